# Optimizing an MI355X kernel written in HIP

```python
import math
import numpy as np
import jax
import jax.numpy as jnp
from jax import lax

D_MODEL = 2048
BATCH = 16
SEQ = 256
DEPTH = 4
DEC_BATCH = 4
DEC_SEQ = 1024
PAST_LEN = 512

GRID_W = 64
HEAD_DIM = 64
SSM_WIDTH = 768
SSM_GROUP = 16
SSM_GROUPS = SSM_WIDTH // SSM_GROUP
SSM_STATE = 64
WIN_HEADS = 12
WIN_KV_HEADS = 4
WIN_GROUP = WIN_HEADS // WIN_KV_HEADS
WINDOW = 128
WIN_BLOCK = 128
NA_HEADS = 12
NA_ROWS = 8
NA_COLS = 16
NA_QBLK = 16
NA_KBLK = 32
CTX_QBLK = 128
N_BRANCH = 3
BRANCH_W = 768
D_FF = 5632
CONV_W = 3
ROPE_BASE = 10000.0
EPS = 1e-6
NEG_INF = -1e30
ATT_SCALE = HEAD_DIM ** -0.5
WIN_Q = WIN_HEADS * HEAD_DIM
WIN_KV = WIN_KV_HEADS * HEAD_DIM
NA_W = NA_HEADS * HEAD_DIM
IN_SPLITS = (SSM_WIDTH, WIN_Q, WIN_KV, WIN_KV, NA_W, NA_W, NA_W, D_MODEL, D_MODEL, D_MODEL)
N_IN = sum(IN_SPLITS)

kernel_name = 'hybrid_diffusion_prefix_trunk_step'


def rmsnorm(x, g):
    xf = x.astype(jnp.float32)
    y = xf * lax.rsqrt(jnp.mean(xf * xf, axis=-1, keepdims=True) + EPS)
    return (y * g.astype(jnp.float32)).astype(x.dtype)


def modulate(h, shift, scale):
    return h * (1.0 + scale) + shift


def adaln(cond, w_mod, b_mod):
    m = jax.nn.silu(cond) @ w_mod + b_mod
    return jnp.split(m, 6, axis=-1)


def split_in(p):
    idx = [int(i) for i in np.cumsum(IN_SPLITS)[:-1]]
    return jnp.split(p, idx, axis=-1)


def heads(t, n):
    return t.reshape(t.shape[:-1] + (n, HEAD_DIM))


def rope_2d(x):
    L = x.shape[1]
    nf = HEAD_DIM // 4
    half = HEAD_DIM // 2
    pos = jnp.arange(L)
    row = (pos // GRID_W).astype(jnp.float32)
    col = (pos % GRID_W).astype(jnp.float32)
    inv = ROPE_BASE ** (-jnp.arange(nf, dtype=jnp.float32) / nf)
    xf = x.astype(jnp.float32)

    def rot(xh, p):
        ang = p[:, None] * inv[None, :]
        cos = jnp.cos(ang)[:, None, :]
        sin = jnp.sin(ang)[:, None, :]
        a, b = xh[..., :nf], xh[..., nf:]
        return jnp.concatenate([a * cos - b * sin, a * sin + b * cos], axis=-1)

    out = jnp.concatenate([rot(xf[..., :half], row), rot(xf[..., half:], col)], axis=-1)
    return out.astype(x.dtype)


def _lin_recur(e1, e2):
    a1, b1 = e1
    a2, b2 = e2
    return a1 * a2, a2 * b1 + b2


def s5_bidir(u, lam_re, lam_im, log_dt, b_re, b_im, c_re, c_im, d_skip, h0_re, h0_im):
    f32 = jnp.float32
    uf = u.astype(f32)
    uc = uf.astype(jnp.complex64)
    lam = lax.complex(lam_re.astype(f32), lam_im.astype(f32))
    dt = jnp.exp(log_dt.astype(f32))[..., None]
    lam_bar = jnp.exp(lam * dt)
    b_bar = ((lam_bar - 1.0) / lam)[..., None] * lax.complex(b_re.astype(f32), b_im.astype(f32))
    c_mat = lax.complex(c_re.astype(f32), c_im.astype(f32))
    h0 = None if h0_re is None else lax.complex(h0_re.astype(f32), h0_im.astype(f32))

    def scan_dir(i, reverse):
        bu = jnp.einsum('blgn,gpn->blgp', uc, b_bar[i])
        if h0 is not None:
            bu = bu.at[:, -1 if reverse else 0].add(lam_bar[i] * h0[:, i])
        a = jnp.broadcast_to(lam_bar[i], bu.shape)
        _, xs = lax.associative_scan(_lin_recur, (a, bu), reverse=reverse, axis=1)
        return xs

    xf = scan_dir(0, False)
    xb = scan_dir(1, True)
    y = jnp.real(jnp.einsum('blgp,gnp->blgn', xf, c_mat[0]) + jnp.einsum('blgp,gnp->blgn', xb, c_mat[1]))
    y = y + d_skip.astype(f32) * uf
    return y.astype(u.dtype), xf, xb


def ssm_mixer(u, lam_re, lam_im, log_dt, b_re, b_im, c_re, c_im, d_skip, w_glu, b_glu, h0_re, h0_im):
    B, L, _ = u.shape
    y, xf, xb = s5_bidir(u.reshape(B, L, SSM_GROUPS, SSM_GROUP), lam_re, lam_im, log_dt,
                         b_re, b_im, c_re, c_im, d_skip, h0_re, h0_im)
    y = jax.nn.gelu(y.reshape(B, L, SSM_WIDTH))
    return y * jax.nn.sigmoid(y @ w_glu + b_glu), xf, xb


def ctx_self_attention(q, k, v, sink):
    B, L, HK, G, d = q.shape
    nb = L // CTX_QBLK
    qb = jnp.moveaxis(q.reshape(B, nb, CTX_QBLK, HK, G, d), 1, 0)

    def one(qi):
        s = jnp.einsum('bqhgd,bkhd->bhgqk', qi, k).astype(jnp.float32) * ATT_SCALE
        if sink is None:
            p = jax.nn.softmax(s, axis=-1)
        else:
            col = jnp.broadcast_to(sink.astype(jnp.float32)[None, :, :, None, None], s.shape[:-1] + (1,))
            p = jax.nn.softmax(jnp.concatenate([s, col], axis=-1), axis=-1)[..., :-1]
        return jnp.einsum('bhgqk,bkhd->bqhgd', p.astype(v.dtype), v)

    o = lax.map(one, qb)
    return jnp.moveaxis(o, 0, 1).reshape(B, L, HK * G * d)


def window_attention_latent(q, k, v, kc, vc, sink):
    B, L, HK, G, d = q.shape
    Lc = kc.shape[1]
    nb = L // WIN_BLOCK
    qb = q.reshape(B, nb, WIN_BLOCK, HK, G, d)

    def bands(t):
        tp = jnp.pad(t, ((0, 0), (WIN_BLOCK, WIN_BLOCK), (0, 0), (0, 0)))
        return jnp.concatenate(
            [tp[:, i * WIN_BLOCK:i * WIN_BLOCK + L].reshape(B, nb, WIN_BLOCK, HK, d) for i in range(3)], axis=2)

    kb, vb = bands(k), bands(v)
    qpos = np.arange(nb)[:, None] * WIN_BLOCK + np.arange(WIN_BLOCK)[None, :]
    kpos = np.arange(nb)[:, None] * WIN_BLOCK - WIN_BLOCK + np.arange(3 * WIN_BLOCK)[None, :]
    valid = ((np.abs(qpos[:, :, None] - kpos[:, None, :]) <= WINDOW)
             & (kpos[:, None, :] >= 0) & (kpos[:, None, :] < L))
    s_loc = jnp.einsum('bnqhgd,bnkhd->bnhgqk', qb, kb).astype(jnp.float32) * ATT_SCALE
    s_loc = jnp.where(valid[None, :, None, None], s_loc, NEG_INF)
    s_ctx = jnp.einsum('bnqhgd,bchd->bnhgqc', qb, kc).astype(jnp.float32) * ATT_SCALE
    col = jnp.broadcast_to(sink.astype(jnp.float32)[None, None, :, :, None, None], s_loc.shape[:-1] + (1,))
    p = jax.nn.softmax(jnp.concatenate([s_loc, s_ctx, col], axis=-1), axis=-1)
    nl = 3 * WIN_BLOCK
    p_loc = p[..., :nl].astype(v.dtype)
    p_ctx = p[..., nl:nl + Lc].astype(v.dtype)
    o = jnp.einsum('bnhgqk,bnkhd->bnqhgd', p_loc, vb) + jnp.einsum('bnhgqc,bchd->bnqhgd', p_ctx, vc)
    return o.reshape(B, L, HK * G * d)


def na_latent(q, k, v, kc, vc, rpb):
    B, L, H, d = q.shape
    R = L // GRID_W
    WR = min(NA_ROWS, R)
    NCB = GRID_W // NA_QBLK
    r = np.arange(R)
    row_start = np.clip(r - WR // 2, 0, R - WR)
    row_idx = row_start[:, None] + np.arange(WR)[None, :]
    j = np.arange(NCB)
    cb_start = np.clip(j * NA_QBLK - NA_COLS // 2, 0, GRID_W - NA_KBLK)
    col_idx = cb_start[:, None] + np.arange(NA_KBLK)[None, :]
    qcol = j[:, None] * NA_QBLK + np.arange(NA_QBLK)[None, :]
    qcol_start = np.clip(qcol - NA_COLS // 2, 0, GRID_W - NA_COLS)
    kcol = col_idx[:, None, :]
    col_valid = (kcol >= qcol_start[:, :, None]) & (kcol < qcol_start[:, :, None] + NA_COLS)
    dr_idx = row_idx - r[:, None] + NA_ROWS - 1
    dc_idx = np.clip(kcol - qcol[:, :, None] + NA_COLS - 1, 0, 2 * NA_COLS - 2)

    krb = k.reshape(B, R, GRID_W, H, d)[:, row_idx][:, :, :, col_idx]
    vrb = v.reshape(B, R, GRID_W, H, d)[:, row_idx][:, :, :, col_idx]
    qg = q.reshape(B, R, NCB, NA_QBLK, H, d)
    s_loc = jnp.einsum('brjqhd,brwjkhd->brjhqwk', qg, krb).astype(jnp.float32) * ATT_SCALE
    bias = rpb.astype(jnp.float32)[:, dr_idx[:, None, None, :, None], dc_idx[None, :, :, None, :]]
    bias = jnp.transpose(bias, (1, 2, 0, 3, 4, 5))
    s_loc = jnp.where(col_valid[None, None, :, None, :, None, :], s_loc + bias[None], NEG_INF)
    nl = WR * NA_KBLK
    s_loc = s_loc.reshape(B, R, NCB, H, NA_QBLK, nl)
    s_ctx = jnp.einsum('brjqhd,bchd->brjhqc', qg, kc).astype(jnp.float32) * ATT_SCALE
    p = jax.nn.softmax(jnp.concatenate([s_loc, s_ctx], axis=-1), axis=-1)
    p_loc = p[..., :nl].reshape(B, R, NCB, H, NA_QBLK, WR, NA_KBLK).astype(v.dtype)
    p_ctx = p[..., nl:].astype(v.dtype)
    o = jnp.einsum('brjhqwk,brwjkhd->brjqhd', p_loc, vrb) + jnp.einsum('brjhqc,bchd->brjqhd', p_ctx, vc)
    return o.reshape(B, L, H * d)


def merge_branches(o_ssm, o_win, o_na, ga, gb, gc, w_branch, w_out):
    m = (jax.nn.sigmoid(ga) * (o_ssm @ w_branch[0])
         + jax.nn.sigmoid(gb) * (o_win @ w_branch[1])
         + jax.nn.sigmoid(gc) * (o_na @ w_branch[2]))
    return m @ w_out


def conv_ffn(h, w_up, conv_w, conv_b, w_down):
    L = h.shape[1]
    u = h @ w_up
    pad = CONV_W // 2
    up = jnp.pad(u, ((0, 0), (pad, pad), (0, 0)))
    u = sum(up[:, i:i + L] * conv_w[i] for i in range(CONV_W)) + conv_b
    a, b = jnp.split(u, 2, axis=-1)
    return (jax.nn.silu(a) * b) @ w_down


def setup_inputs(seed: int = 0) -> dict:
    key = jax.random.key(seed)
    ks = iter(jax.random.split(key, 48))
    f32 = jnp.float32

    def nrm(shape, scale):
        return jax.random.normal(next(ks), shape, f32) * scale

    n = jnp.arange(SSM_STATE, dtype=f32)
    return {
        'x_prompt': nrm((BATCH, SEQ, D_MODEL), 1.0),
        'x_sample': nrm((DEC_BATCH, DEC_SEQ, D_MODEL), 1.0),
        'cache_win_k': nrm((DEC_BATCH, DEPTH, PAST_LEN, WIN_KV_HEADS, HEAD_DIM), 1.0),
        'cache_win_v': nrm((DEC_BATCH, DEPTH, PAST_LEN, WIN_KV_HEADS, HEAD_DIM), 1.0),
        'cache_na_k': nrm((DEC_BATCH, DEPTH, PAST_LEN, NA_HEADS, HEAD_DIM), 1.0),
        'cache_na_v': nrm((DEC_BATCH, DEPTH, PAST_LEN, NA_HEADS, HEAD_DIM), 1.0),
        'state_ssm_re': nrm((DEC_BATCH, DEPTH, 2, SSM_GROUPS, SSM_STATE), 0.1),
        'state_ssm_im': nrm((DEC_BATCH, DEPTH, 2, SSM_GROUPS, SSM_STATE), 0.1),
        'c': nrm((DEC_BATCH, D_MODEL), 1.0),
        'c_ctx': nrm((D_MODEL,), 1.0),
        'norm1_g': 1.0 + nrm((DEPTH, D_MODEL), 0.02),
        'norm2_g': 1.0 + nrm((DEPTH, D_MODEL), 0.02),
        'w_mod': nrm((DEPTH, D_MODEL, 6 * D_MODEL), D_MODEL ** -0.5),
        'b_mod': nrm((DEPTH, 6 * D_MODEL), 0.01),
        'w_in': nrm((DEPTH, D_MODEL, N_IN), D_MODEL ** -0.5),
        'ssm_lam_re': -0.5 + nrm((DEPTH, 2, SSM_GROUPS, SSM_STATE), 0.01),
        'ssm_lam_im': jnp.pi * n + nrm((DEPTH, 2, SSM_GROUPS, SSM_STATE), 0.01),
        'ssm_log_dt': jax.random.uniform(next(ks), (DEPTH, 2, SSM_GROUPS), f32, math.log(1e-3), math.log(1e-1)),
        'ssm_b_re': nrm((DEPTH, 2, SSM_GROUPS, SSM_STATE, SSM_GROUP), (2 * SSM_GROUP) ** -0.5),
        'ssm_b_im': nrm((DEPTH, 2, SSM_GROUPS, SSM_STATE, SSM_GROUP), (2 * SSM_GROUP) ** -0.5),
        'ssm_c_re': nrm((DEPTH, 2, SSM_GROUPS, SSM_GROUP, SSM_STATE), SSM_STATE ** -0.5),
        'ssm_c_im': nrm((DEPTH, 2, SSM_GROUPS, SSM_GROUP, SSM_STATE), SSM_STATE ** -0.5),
        'ssm_d': nrm((DEPTH, SSM_GROUPS, SSM_GROUP), 1.0),
        'w_glu': nrm((DEPTH, SSM_WIDTH, SSM_WIDTH), SSM_WIDTH ** -0.5),
        'b_glu': nrm((DEPTH, SSM_WIDTH), 0.01),
        'win_sink': nrm((DEPTH, WIN_HEADS), 0.5),
        'na_rpb': nrm((DEPTH, NA_HEADS, 2 * NA_ROWS - 1, 2 * NA_COLS - 1), 0.1),
        'w_branch': nrm((DEPTH, N_BRANCH, BRANCH_W, D_MODEL), BRANCH_W ** -0.5),
        'w_out': nrm((DEPTH, D_MODEL, D_MODEL), D_MODEL ** -0.5),
        'w_up': nrm((DEPTH, D_MODEL, 2 * D_FF), D_MODEL ** -0.5),
        'conv_w': nrm((DEPTH, CONV_W, 2 * D_FF), 0.5),
        'conv_b': nrm((DEPTH, 2 * D_FF), 0.01),
        'w_down': nrm((DEPTH, D_FF, D_MODEL), D_FF ** -0.5),
        'final_g': 1.0 + nrm((D_MODEL,), 0.02),
    }


def reference(x_prompt, x_sample, cache_win_k, cache_win_v, cache_na_k, cache_na_v, state_ssm_re, state_ssm_im,
              c, c_ctx, norm1_g, norm2_g, w_mod, b_mod, w_in, ssm_lam_re, ssm_lam_im, ssm_log_dt,
              ssm_b_re, ssm_b_im, ssm_c_re, ssm_c_im, ssm_d, w_glu, b_glu, win_sink, na_rpb,
              w_branch, w_out, w_up, conv_w, conv_b, w_down, final_g):
    xp, xs = x_prompt, x_sample
    Bp, Lp, _ = xp.shape
    Bs, Ls, _ = xs.shape
    new_wk, new_wv, new_nk, new_nv, new_sre, new_sim = [], [], [], [], [], []
    for l in range(DEPTH):
        ssm_p = (ssm_lam_re[l], ssm_lam_im[l], ssm_log_dt[l], ssm_b_re[l], ssm_b_im[l],
                 ssm_c_re[l], ssm_c_im[l], ssm_d[l], w_glu[l], b_glu[l])
        sink = win_sink[l].reshape(WIN_KV_HEADS, WIN_GROUP)

        sh1, sc1, g1, sh2, sc2, g2 = adaln(c_ctx, w_mod[l], b_mod[l])
        h = modulate(rmsnorm(xp, norm1_g[l]), sh1, sc1)
        u, qw, kw, vw, qn, kn, vn, ga, gb, gc = split_in(h @ w_in[l])
        kw, vw = heads(kw, WIN_KV_HEADS), heads(vw, WIN_KV_HEADS)
        kn, vn = heads(kn, NA_HEADS), heads(vn, NA_HEADS)
        o_ssm, xf, xb = ssm_mixer(u, *ssm_p, None, None)
        fin = jnp.stack([xf[:, -1], xb[:, 0]], axis=1)
        o_win = ctx_self_attention(qw.reshape(Bp, Lp, WIN_KV_HEADS, WIN_GROUP, HEAD_DIM), kw, vw, sink)
        o_na = ctx_self_attention(qn.reshape(Bp, Lp, NA_HEADS, 1, HEAD_DIM), kn, vn, None)
        xp = xp + g1 * merge_branches(o_ssm, o_win, o_na, ga, gb, gc, w_branch[l], w_out[l])
        h = modulate(rmsnorm(xp, norm2_g[l]), sh2, sc2)
        xp = xp + g2 * conv_ffn(h, w_up[l], conv_w[l], conv_b[l], w_down[l])
        new_wk.append(kw)
        new_wv.append(vw)
        new_nk.append(kn)
        new_nv.append(vn)
        new_sre.append(jnp.real(fin))
        new_sim.append(jnp.imag(fin))

        sh1, sc1, g1, sh2, sc2, g2 = [t[:, None, :] for t in adaln(c, w_mod[l], b_mod[l])]
        h = modulate(rmsnorm(xs, norm1_g[l]), sh1, sc1)
        u, qw, kw, vw, qn, kn, vn, ga, gb, gc = split_in(h @ w_in[l])
        o_ssm, _, _ = ssm_mixer(u, *ssm_p, state_ssm_re[:, l], state_ssm_im[:, l])
        qw = rope_2d(heads(qw, WIN_HEADS)).reshape(Bs, Ls, WIN_KV_HEADS, WIN_GROUP, HEAD_DIM)
        kw = rope_2d(heads(kw, WIN_KV_HEADS))
        o_win = window_attention_latent(qw, kw, heads(vw, WIN_KV_HEADS), cache_win_k[:, l], cache_win_v[:, l], sink)
        o_na = na_latent(heads(qn, NA_HEADS), heads(kn, NA_HEADS), heads(vn, NA_HEADS),
                         cache_na_k[:, l], cache_na_v[:, l], na_rpb[l])
        xs = xs + g1 * merge_branches(o_ssm, o_win, o_na, ga, gb, gc, w_branch[l], w_out[l])
        h = modulate(rmsnorm(xs, norm2_g[l]), sh2, sc2)
        xs = xs + g2 * conv_ffn(h, w_up[l], conv_w[l], conv_b[l], w_down[l])

    y_prompt = rmsnorm(xp, final_g)
    y_sample = rmsnorm(xs, final_g)
    new_win_k = jnp.stack(new_wk, axis=1)
    new_win_v = jnp.stack(new_wv, axis=1)
    new_na_k = jnp.stack(new_nk, axis=1)
    new_na_v = jnp.stack(new_nv, axis=1)
    new_ssm_re = jnp.stack(new_sre, axis=1)
    new_ssm_im = jnp.stack(new_sim, axis=1)
    return (y_prompt, y_sample, new_win_k, new_win_v, new_na_k, new_na_v, new_ssm_re, new_ssm_im)
```

```cpp
#include <hip/hip_runtime.h>
#include <cstdio>
#include <cstdint>

constexpr int DM = 2048, DEPTH = 4;
constexpr int CB = 16, CL = 256, SB = 4, SL = 1024, PAST = 512;
constexpr int NCTX = CB * CL, NLAT = SB * SL, NTOK = NCTX + NLAT;
constexpr int HD = 64, SSMW = 768, SG = 48, SP = 64, SN = 16;
constexpr int WINH = 12, WINKV = 4, NAH = 12;
constexpr int DFF = 5632, NUP = 2 * DFF;
constexpr int NIN = 10496;
constexpr int C_U = 0, C_QW = 768, C_KW = 1536, C_VW = 1792, C_QN = 2048, C_KN = 2816, C_VN = 3584, C_GA = 4352, C_GB = 6400, C_GC = 8448;
constexpr size_t O_YP = 0, O_YS = O_YP + (size_t)NCTX * DM, O_WK = O_YS + (size_t)NLAT * DM;
constexpr size_t SZ_WKV = (size_t)CB * DEPTH * CL * WINKV * HD, SZ_NKV = (size_t)CB * DEPTH * CL * NAH * HD, SZ_SS = (size_t)CB * DEPTH * 2 * SG * SP;
constexpr size_t O_WV = O_WK + SZ_WKV, O_NK = O_WV + SZ_WKV, O_NV = O_NK + SZ_NKV, O_SR = O_NV + SZ_NKV, O_SI = O_SR + SZ_SS, O_END = O_SI + SZ_SS;

struct In {
    const float *x_prompt, *x_sample, *cwk, *cwv, *cnk, *cnv, *st_re, *st_im, *c, *c_ctx, *norm1_g, *norm2_g, *w_mod, *b_mod, *w_in,
        *lam_re, *lam_im, *log_dt, *b_re, *b_im, *c_re, *c_im, *ssm_d, *w_glu, *b_glu, *win_sink, *na_rpb, *w_branch, *w_out, *w_up, *conv_w, *conv_b, *w_down, *final_g;
};

__device__ __forceinline__ float sigmoidf_(float x) { return 1.f / (1.f + expf(-x)); }
__device__ __forceinline__ float siluf_(float x) { return x / (1.f + expf(-x)); }
__device__ __forceinline__ float gelu_tanh(float x) { const float k = 0.7978845608028654f; return 0.5f * x * (1.f + tanhf(k * (x + 0.044715f * x * x * x))); }
__device__ __forceinline__ int cond_of(int tok) { return tok < NCTX ? 0 : 1 + (tok - NCTX) / SL; }

__global__ void __launch_bounds__(256) k_adaln(In in, float* mod) {
    const int l = blockIdx.y, n = blockIdx.x * 256 + threadIdx.x;
    __shared__ float sc[5][256];
    float acc[5] = {0.f, 0.f, 0.f, 0.f, 0.f};
    const float* W = in.w_mod + (size_t)l * DM * 6 * DM;
    for (int k0 = 0; k0 < DM; k0 += 256) {
        __syncthreads();
        for (int j = 0; j < 5; ++j) { const float v = j == 0 ? in.c_ctx[k0 + threadIdx.x] : in.c[(j - 1) * DM + k0 + threadIdx.x]; sc[j][threadIdx.x] = siluf_(v); }
        __syncthreads();
        for (int k = 0; k < 256; ++k) { const float w = W[(size_t)(k0 + k) * (6 * DM) + n];
#pragma unroll
            for (int j = 0; j < 5; ++j) acc[j] += sc[j][k] * w; }
    }
    const float b = in.b_mod[(size_t)l * 6 * DM + n];
#pragma unroll
    for (int j = 0; j < 5; ++j) mod[((size_t)l * 5 + j) * 6 * DM + n] = acc[j] + b;
}

__global__ void __launch_bounds__(256) k_norm(const float* X, const float* g, const float* mod_l  , int s_shift, int s_scale, float* out) {
    const int tok = blockIdx.x, tid = threadIdx.x;
    const float* x = X + (size_t)tok * DM;
    float v[8]; float ss = 0.f;
#pragma unroll
    for (int i = 0; i < 8; ++i) { v[i] = x[tid + 256 * i]; ss += v[i] * v[i]; }
    __shared__ float red[256];
    red[tid] = ss; __syncthreads();
    for (int s = 128; s > 0; s >>= 1) { if (tid < s) red[tid] += red[tid + s]; __syncthreads(); }
    const float r = rsqrtf(red[0] / DM + 1e-6f);
    const float* m = mod_l ? mod_l + (size_t)cond_of(tok) * 6 * DM : nullptr;
#pragma unroll
    for (int i = 0; i < 8; ++i) { const int c = tid + 256 * i; float y = v[i] * r * g[c]; if (m) y = y * (1.f + m[s_scale * DM + c]) + m[s_shift * DM + c]; out[(size_t)tok * DM + c] = y; }
}

struct Epi { float* C; const float* aux; const float* bias; const float* mod_l; int mode, ldc, ldaux, s_gate; };
__global__ void __launch_bounds__(256) k_gemm(const float* A, int lda, const float* B, int ldb, int K, Epi e) {
    __shared__ float As[16][132]; __shared__ float Bs[16][128];
    const int tid = threadIdx.x, tx = tid & 15, ty = tid >> 4, m0 = blockIdx.y * 128, n0 = blockIdx.x * 128;
    float acc[8][8];
#pragma unroll
    for (int i = 0; i < 8; ++i)
#pragma unroll
        for (int j = 0; j < 8; ++j) acc[i][j] = 0.f;
    for (int k0 = 0; k0 < K; k0 += 16) {
        __syncthreads();
#pragma unroll
        for (int i = 0; i < 2; ++i) { const int r = (tid >> 2) + 64 * i, kc = (tid & 3) * 4; const float4 a = *(const float4*)(A + (size_t)(m0 + r) * lda + k0 + kc);
            As[kc + 0][r] = a.x; As[kc + 1][r] = a.y; As[kc + 2][r] = a.z; As[kc + 3][r] = a.w; }
#pragma unroll
        for (int i = 0; i < 2; ++i) { const int k = (tid >> 5) + 8 * i, n = (tid & 31) * 4; *(float4*)&Bs[k][n] = *(const float4*)(B + (size_t)(k0 + k) * ldb + n0 + n); }
        __syncthreads();
#pragma unroll
        for (int k = 0; k < 16; ++k) {
            float a[8], b[8];
#pragma unroll
            for (int i = 0; i < 8; ++i) a[i] = As[k][ty * 8 + i];
#pragma unroll
            for (int j = 0; j < 8; ++j) b[j] = Bs[k][tx * 8 + j];
#pragma unroll
            for (int i = 0; i < 8; ++i)
#pragma unroll
                for (int j = 0; j < 8; ++j) acc[i][j] += a[i] * b[j];
        }
    }
#pragma unroll
    for (int i = 0; i < 8; ++i) { const int row = m0 + ty * 8 + i;
#pragma unroll
        for (int j = 0; j < 8; ++j) { const int col = n0 + tx * 8 + j; float* c = e.C + (size_t)row * e.ldc + col; const float a = acc[i][j];
            if (e.mode == 0) *c = a;
            else if (e.mode == 1) *c = e.aux[(size_t)row * e.ldaux + col] * sigmoidf_(a + e.bias[col]);
            else if (e.mode == 2) *c = sigmoidf_(e.aux[(size_t)row * e.ldaux + col]) * a;
            else if (e.mode == 3) *c += sigmoidf_(e.aux[(size_t)row * e.ldaux + col]) * a;
            else *c += e.mod_l[(size_t)cond_of(row) * 6 * DM + e.s_gate * DM + col] * a; } }
}

__global__ void __launch_bounds__(256) k_write_kv(const float* P, int l, float* out) {
    const int tok = blockIdx.x, b = tok / CL, t = tok % CL;
    const float* p = P + (size_t)tok * NIN;
    for (int i = threadIdx.x; i < 256; i += 256) {
        out[O_WK + (((size_t)b * DEPTH + l) * CL + t) * 256 + i] = p[C_KW + i];
        out[O_WV + (((size_t)b * DEPTH + l) * CL + t) * 256 + i] = p[C_VW + i];
    }
    for (int i = threadIdx.x; i < 768; i += 256) {
        out[O_NK + (((size_t)b * DEPTH + l) * CL + t) * 768 + i] = p[C_KN + i];
        out[O_NV + (((size_t)b * DEPTH + l) * CL + t) * 768 + i] = p[C_VN + i];
    }
}

__global__ void __launch_bounds__(256) k_rope(float* P) {
    const int tok = NCTX + blockIdx.x, pos = (tok - NCTX) % SL, row = pos / 64, col = pos % 64;
    float* p = P + (size_t)tok * NIN + C_QW;
    for (int w = threadIdx.x; w < 16 * 32; w += 256) {
        const int h = w >> 5, r = w & 31, half = r >> 4, i = r & 15;
        const float inv = powf(10000.f, -(float)i / 16.f), ang = (half == 0 ? (float)row : (float)col) * inv;
        const float cs = cosf(ang), sn = sinf(ang);
        float* q = p + h * 64 + half * 32;
        const float a = q[i], b = q[i + 16];
        q[i] = a * cs - b * sn; q[i + 16] = a * sn + b * cs;
    }
}

__device__ __forceinline__ void sincos_d(double x, double& s, double& c) {
    const double k = rint(x * 0.6366197723675814); const double r = (x - k * 1.5707963267948966) - k * 6.123233995736766e-17;
    const double r2 = r * r;
    double sp = r * (1.0 + r2 * (-1.0 / 6 + r2 * (1.0 / 120 + r2 * (-1.0 / 5040 + r2 * (1.0 / 362880 + r2 * (-1.0 / 39916800 + r2 * (1.0 / 6227020800.0 + r2 * (-1.0 / 1307674368000.0))))))));
    double cp = 1.0 + r2 * (-0.5 + r2 * (1.0 / 24 + r2 * (-1.0 / 720 + r2 * (1.0 / 40320 + r2 * (-1.0 / 3628800 + r2 * (1.0 / 479001600.0 + r2 * (-1.0 / 87178291200.0 + r2 * (1.0 / 20922789888000.0))))))));
    const int q = ((int)k) & 3;
    if (q == 0) { s = sp; c = cp; } else if (q == 1) { s = cp; c = -sp; } else if (q == 2) { s = -sp; c = -cp; } else { s = -cp; c = sp; }
}
__global__ void __launch_bounds__(64) k_ssm(In in, const float* P, int l, float* Ypart  , float* out) {
    const int dir = blockIdx.x & 1, g = (blockIdx.x >> 1) % SG, bb = blockIdx.x / (2 * SG), p = threadIdx.x;
    const bool ctx = bb < CB; const int base = ctx ? bb * CL : NCTX + (bb - CB) * SL, L = ctx ? CL : SL;
    const size_t pi = (((size_t)l * 2 + dir) * SG + g) * SP + p;
    const double lr = in.lam_re[pi], li = in.lam_im[pi], dt = exp((double)in.log_dt[((size_t)l * 2 + dir) * SG + g]);
    double sn, cs; sincos_d(li * dt, sn, cs);
    const double er = exp(lr * dt), lbr = er * cs, lbi = er * sn;
    const double nr = lbr - 1.0, ni = lbi, den = lr * lr + li * li, cr = (nr * lr + ni * li) / den, ci = (ni * lr - nr * li) / den;
    float bbr[SN], bbi[SN];
#pragma unroll
    for (int n = 0; n < SN; ++n) { const double br = in.b_re[pi * SN + n], bi = in.b_im[pi * SN + n]; bbr[n] = (float)(cr * br - ci * bi); bbi[n] = (float)(cr * bi + ci * br); }
    const float ar = (float)lbr, ai = (float)lbi;
    __shared__ float cre[SN][SP], cim[SN][SP], xr[16][SP + 1], xi[16][SP + 1];
    for (int n = 0; n < SN; ++n) { const size_t ci_ = ((((size_t)l * 2 + dir) * SG + g) * SN + n) * SP + p; cre[n][p] = in.c_re[ci_]; cim[n][p] = in.c_im[ci_]; }
    float sr = 0.f, si = 0.f;
    if (!ctx) { const size_t hi = ((((size_t)(bb - CB) * DEPTH + l) * 2 + dir) * SG + g) * SP + p; sr = in.st_re[hi]; si = in.st_im[hi]; }
    __syncthreads();
    for (int c0 = 0; c0 < L; c0 += 16) {
        for (int s = 0; s < 16; ++s) {
            const int t = dir == 0 ? c0 + s : L - 1 - (c0 + s);
            const float* u = P + (size_t)(base + t) * NIN + C_U + g * SN;
            float br = 0.f, bi = 0.f;
#pragma unroll
            for (int n = 0; n < SN; ++n) { const float uv = u[n]; br += bbr[n] * uv; bi += bbi[n] * uv; }
            const float nr_ = ar * sr - ai * si + br, ni_ = ar * si + ai * sr + bi;
            sr = nr_; si = ni_;
            xr[s][p] = sr; xi[s][p] = si;
        }
        __syncthreads();
        const int s = p >> 2, nq = p & 3;
        const int t = dir == 0 ? c0 + s : L - 1 - (c0 + s);
#pragma unroll
        for (int j = 0; j < 4; ++j) { const int n = nq * 4 + j; float y = 0.f;
            for (int q = 0; q < SP; ++q) y += cre[n][q] * xr[s][q] - cim[n][q] * xi[s][q];
            Ypart[((size_t)dir * NTOK + base + t) * SSMW + g * SN + n] = y; }
        __syncthreads();
    }
    if (ctx) { const size_t oi = ((((size_t)bb * DEPTH + l) * 2 + dir) * SG + g) * SP + p; out[O_SR + oi] = sr; out[O_SI + oi] = si; }
}
__global__ void __launch_bounds__(256) k_ssm_post(In in, const float* P, const float* Ypart, int l, float* Yg) {
    const int tok = blockIdx.x;
    for (int c = threadIdx.x; c < SSMW; c += 256) {
        const float y = Ypart[(size_t)tok * SSMW + c] + Ypart[((size_t)NTOK + tok) * SSMW + c] + in.ssm_d[(size_t)l * SSMW + c] * P[(size_t)tok * NIN + C_U + c];
        Yg[(size_t)tok * SSMW + c] = gelu_tanh(y);
    }
}

struct OnlineSm { float m, l; float o[HD]; };
__device__ __forceinline__ void sm_key(OnlineSm& S, const float (&q)[HD], const float* k, const float* v, float bias) {
    float s = 0.f;
#pragma unroll
    for (int d = 0; d < HD; d += 4) { const float4 kk = *(const float4*)(k + d); s += q[d] * kk.x + q[d + 1] * kk.y + q[d + 2] * kk.z + q[d + 3] * kk.w; }
    s = s * 0.125f + bias;
    const float mn = fmaxf(S.m, s), corr = expf(S.m - mn), pp = expf(s - mn);
    S.l = S.l * corr + pp; S.m = mn;
#pragma unroll
    for (int d = 0; d < HD; d += 4) { const float4 vv = *(const float4*)(v + d); S.o[d] = S.o[d] * corr + pp * vv.x; S.o[d + 1] = S.o[d + 1] * corr + pp * vv.y; S.o[d + 2] = S.o[d + 2] * corr + pp * vv.z; S.o[d + 3] = S.o[d + 3] * corr + pp * vv.w; }
}
__global__ void __launch_bounds__(64) k_attn(In in, const float* P, int l, int mixer, float* O  ) {
    const int tok = blockIdx.x * 64 + threadIdx.x, h = blockIdx.y;
    const bool ctx = tok < NCTX;
    const float* prow = P + (size_t)tok * NIN;
    float q[HD];
    const int qoff = mixer == 0 ? C_QW + h * HD : C_QN + h * HD;
#pragma unroll
    for (int d = 0; d < HD; d += 4) { const float4 t = *(const float4*)(prow + qoff + d); q[d] = t.x; q[d + 1] = t.y; q[d + 2] = t.z; q[d + 3] = t.w; }
    OnlineSm S; S.m = -3.0e38f; S.l = 0.f;
#pragma unroll
    for (int d = 0; d < HD; ++d) S.o[d] = 0.f;
    const int koff = mixer == 0 ? C_KW + (h / 3) * HD : C_KN + h * HD, voff = mixer == 0 ? C_VW + (h / 3) * HD : C_VN + h * HD;
    if (ctx) {
        const int b = tok / CL;
        for (int j = 0; j < CL; ++j) { const float* kr = P + (size_t)(b * CL + j) * NIN; sm_key(S, q, kr + koff, kr + voff, 0.f); }
    } else {
        const int b = (tok - NCTX) / SL, pos = (tok - NCTX) % SL, base = NCTX + b * SL;
        if (mixer == 0) {
            const int lo = pos - 128 < 0 ? 0 : pos - 128, hi = pos + 128 > SL - 1 ? SL - 1 : pos + 128;
            for (int j = lo; j <= hi; ++j) { const float* kr = P + (size_t)(base + j) * NIN; sm_key(S, q, kr + koff, kr + voff, 0.f); }
            const int hk = h / 3;
            for (int c = 0; c < PAST; ++c) { const size_t o = ((((size_t)b * DEPTH + l) * PAST + c) * WINKV + hk) * HD; sm_key(S, q, in.cwk + o, in.cwv + o, 0.f); }
        } else {
            const int r = pos / 64, cc = pos % 64;
            int rs = r - 4; rs = rs < 0 ? 0 : (rs > 8 ? 8 : rs);
            int cs = cc - 8; cs = cs < 0 ? 0 : (cs > 48 ? 48 : cs);
            const float* rpb = in.na_rpb + ((size_t)l * NAH + h) * 15 * 31;
            for (int kr_ = rs; kr_ < rs + 8; ++kr_)
                for (int kc = cs; kc < cs + 16; ++kc) { const float* kr = P + (size_t)(base + kr_ * 64 + kc) * NIN; const float bias = rpb[(kr_ - r + 7) * 31 + (kc - cc + 15)]; sm_key(S, q, kr + koff, kr + voff, bias); }
            for (int c = 0; c < PAST; ++c) { const size_t o = ((((size_t)b * DEPTH + l) * PAST + c) * NAH + h) * HD; sm_key(S, q, in.cnk + o, in.cnv + o, 0.f); }
        }
    }
    if (mixer == 0) { const float sk = in.win_sink[l * WINH + h]; const float mn = fmaxf(S.m, sk), corr = expf(S.m - mn); S.l = S.l * corr + expf(sk - mn);
#pragma unroll
        for (int d = 0; d < HD; ++d) S.o[d] *= corr; }
    const float inv = 1.f / S.l;
#pragma unroll
    for (int d = 0; d < HD; ++d) O[(size_t)tok * 768 + h * HD + d] = S.o[d] * inv;
}

__global__ void __launch_bounds__(256) k_conv_act(In in, const float* U, int l, float* act) {
    const int tok = blockIdx.x; int t, L;
    if (tok < NCTX) { t = tok % CL; L = CL; } else { t = (tok - NCTX) % SL; L = SL; }
    const float* cw = in.conv_w + (size_t)l * 3 * NUP; const float* cb = in.conv_b + (size_t)l * NUP;
    const float* u0 = U + (size_t)tok * NUP;
    for (int j = threadIdx.x; j < DFF; j += 256) {
        float a = cb[j] + cw[NUP + j] * u0[j], b = cb[DFF + j] + cw[NUP + DFF + j] * u0[DFF + j];
        if (t > 0) { a += cw[j] * u0[j - NUP]; b += cw[DFF + j] * u0[DFF + j - NUP]; }
        if (t < L - 1) { a += cw[2 * NUP + j] * u0[j + NUP]; b += cw[2 * NUP + DFF + j] * u0[DFF + j + NUP]; }
        act[(size_t)tok * DFF + j] = siluf_(a) * b;
    }
}

extern "C" void kernel_launch(void* const* d_in, const int* in_sizes, int n_in, void* d_out, int out_size, void* d_ws, size_t ws_size, hipStream_t stream) {
    In in; { const float** f = (const float**)&in; for (int i = 0; i < 34; ++i) f[i] = (const float*)d_in[i]; }
    float* out = (float*)d_out;
    char* ws = (char*)d_ws; size_t off = 0;
    auto carve = [&](size_t bytes) { float* p = (float*)(ws + off); off += (bytes + 255) & ~(size_t)255; return p; };
    float* mod = carve((size_t)DEPTH * 5 * 6 * DM * 4);
    float* X = carve((size_t)NTOK * DM * 4);
    float* H = carve((size_t)NTOK * DM * 4);
    float* PU = carve((size_t)NTOK * NUP * 4);
    float* Ypart = carve((size_t)2 * NTOK * SSMW * 4);
    float* Yg = carve((size_t)NTOK * SSMW * 4);
    float* Ossm = carve((size_t)NTOK * SSMW * 4);
    float* Owin = carve((size_t)NTOK * SSMW * 4);
    float* Ona = carve((size_t)NTOK * SSMW * 4);
    float* Mb = carve((size_t)NTOK * DM * 4);
    float* act = carve((size_t)NTOK * DFF * 4);
    if (off > ws_size) { fprintf(stderr, "ws too small: need %zu have %zu\n", off, ws_size); return; }
    hipMemcpyAsync(X, in.x_prompt, (size_t)NCTX * DM * 4, hipMemcpyDeviceToDevice, stream);
    hipMemcpyAsync(X + (size_t)NCTX * DM, in.x_sample, (size_t)NLAT * DM * 4, hipMemcpyDeviceToDevice, stream);
    k_adaln<<<dim3(6 * DM / 256, DEPTH), 256, 0, stream>>>(in, mod);
    for (int l = 0; l < DEPTH; ++l) {
        const float* mod_l = mod + (size_t)l * 5 * 6 * DM;
        k_norm<<<NTOK, 256, 0, stream>>>(X, in.norm1_g + (size_t)l * DM, mod_l, 0, 1, H);
        { Epi e{PU, nullptr, nullptr, nullptr, 0, NIN, 0, 0}; k_gemm<<<dim3(NIN / 128, NTOK / 128), 256, 0, stream>>>(H, DM, in.w_in + (size_t)l * DM * NIN, NIN, DM, e); }
        k_write_kv<<<NCTX, 256, 0, stream>>>(PU, l, out);
        k_rope<<<NLAT, 256, 0, stream>>>(PU);
        k_ssm<<<(CB + SB) * SG * 2, 64, 0, stream>>>(in, PU, l, Ypart, out);
        k_ssm_post<<<NTOK, 256, 0, stream>>>(in, PU, Ypart, l, Yg);
        { Epi e{Ossm, Yg, in.b_glu + (size_t)l * SSMW, nullptr, 1, SSMW, SSMW, 0}; k_gemm<<<dim3(SSMW / 128, NTOK / 128), 256, 0, stream>>>(Yg, SSMW, in.w_glu + (size_t)l * SSMW * SSMW, SSMW, SSMW, e); }
        k_attn<<<dim3(NTOK / 64, WINH), 64, 0, stream>>>(in, PU, l, 0, Owin);
        k_attn<<<dim3(NTOK / 64, NAH), 64, 0, stream>>>(in, PU, l, 1, Ona);
        const float* wb = in.w_branch + (size_t)l * 3 * SSMW * DM;
        { Epi e{Mb, PU + C_GA, nullptr, nullptr, 2, DM, NIN, 0}; k_gemm<<<dim3(DM / 128, NTOK / 128), 256, 0, stream>>>(Ossm, SSMW, wb, DM, SSMW, e); }
        { Epi e{Mb, PU + C_GB, nullptr, nullptr, 3, DM, NIN, 0}; k_gemm<<<dim3(DM / 128, NTOK / 128), 256, 0, stream>>>(Owin, SSMW, wb + (size_t)SSMW * DM, DM, SSMW, e); }
        { Epi e{Mb, PU + C_GC, nullptr, nullptr, 3, DM, NIN, 0}; k_gemm<<<dim3(DM / 128, NTOK / 128), 256, 0, stream>>>(Ona, SSMW, wb + (size_t)2 * SSMW * DM, DM, SSMW, e); }
        { Epi e{X, nullptr, nullptr, mod_l, 4, DM, 0, 2}; k_gemm<<<dim3(DM / 128, NTOK / 128), 256, 0, stream>>>(Mb, DM, in.w_out + (size_t)l * DM * DM, DM, DM, e); }
        k_norm<<<NTOK, 256, 0, stream>>>(X, in.norm2_g + (size_t)l * DM, mod_l, 3, 4, H);
        { Epi e{PU, nullptr, nullptr, nullptr, 0, NUP, 0, 0}; k_gemm<<<dim3(NUP / 128, NTOK / 128), 256, 0, stream>>>(H, DM, in.w_up + (size_t)l * DM * NUP, NUP, DM, e); }
        k_conv_act<<<NTOK, 256, 0, stream>>>(in, PU, l, act);
        { Epi e{X, nullptr, nullptr, mod_l, 4, DM, 0, 5}; k_gemm<<<dim3(DM / 128, NTOK / 128), 256, 0, stream>>>(act, DFF, in.w_down + (size_t)l * DFF * DM, DM, DFF, e); }
    }
    k_norm<<<NTOK, 256, 0, stream>>>(X, in.final_g, nullptr, 0, 0, out);
}
```

```cpp
#include <hip/hip_runtime.h>
#include <cstdio>
#include <cstdint>

#define MK_PER_PHASE 0

namespace pg8 {
#define PG8_LAS __attribute__((address_space(3)))
typedef unsigned short bf16_t;
typedef short bf16x8 __attribute__((ext_vector_type(8)));
typedef float f32x4 __attribute__((ext_vector_type(4)));
typedef unsigned u32x4 __attribute__((ext_vector_type(4)));
constexpr int BM = 256, BK = 64, HALF = 128, HTB = HALF * BK * 2  , STAGE_BYTES = 8 * HTB, NXCD = 8, WGM = 8;

__host__ __device__ __forceinline__ int lds_byte(int r, int c) { const int st = (r >> 4) * 2 + (c >> 5), rr = r & 15, cc = c & 31, ob = rr * 64 + cc * 2; return st * 1024 + (ob ^ (((ob >> 9) & 1) << 5)); }
__host__ __device__ __forceinline__ void stage_rc(int b, int& R, int& C) { const int st = b / 1024, sb = b % 1024, swz = sb ^ (((sb >> 9) & 1) << 5); R = (st >> 1) * 16 + swz / 64; C = (st & 1) * 32 + (swz % 64) / 2; }
__host__ __device__ __forceinline__ int perm32(int rho) { const int n = rho >> 4, i = rho & 15; return 8 * (i >> 2) + 4 * n + (i & 3); }

struct Unit { int pm, pn; };
struct Gemm { const bf16_t* A; const bf16_t* Bt; int M, N, K; };

struct StaticOrder {
    int nM, nN, nwg, G, c;
    __host__ __device__ void init(int M, int N, int G_, int c_) { nM = M / BM; nN = N / BM; nwg = nM * nN; G = G_; c = c_; }
    __host__ __device__ bool next(int i, Unit& u) const {
        const long L = (long)i * G + c; if (L >= nwg) return false;
        int wgid = (int)L; { const int q = nwg / NXCD, r = nwg % NXCD, xcd = wgid % NXCD, off = wgid / NXCD; wgid = (xcd < r ? xcd * (q + 1) : r * (q + 1) + (xcd - r) * q) + off; }
        const int nig = WGM * nN, gid = wgid / nig, fm = gid * WGM, gsz = (nM - fm) < WGM ? (nM - fm) : WGM;
        u.pm = fm + ((wgid % nig) % gsz); u.pn = (wgid % nig) / gsz; return true;
    }
    __device__ __forceinline__ void a_ready(const Unit&) const {}
    __device__ __forceinline__ void done(const Unit&) const {}
};
__device__ __forceinline__ unsigned cvt_pk_bf16(float lo, float hi) { unsigned r; asm volatile("v_cvt_pk_bf16_f32 %0, %1, %2" : "=v"(r) : "v"(lo), "v"(hi)); return r; }
typedef float f32x2 __attribute__((ext_vector_type(2)));
template <class Epi, class Sched, bool ALIGN_EPI = false, bool SP2 = false>
__device__ __forceinline__ void gemm_phase(PG8_LAS unsigned char* lds, const Gemm g, const Sched& S, const Epi& E) {
    int tid_ = threadIdx.x; asm volatile("" : "+v"(tid_));
    const int tid = tid_, wid = __builtin_amdgcn_readfirstlane(tid >> 6), lane = tid & 63, wr = wid >> 2, wc = wid & 3, fr = lane & 15, fq = lane >> 4;
    const int K = g.K, nt = K / BK;
    unsigned voffA[2], voffB[2];
#pragma unroll
    for (int i = 0; i < 2; ++i) { int R, C; stage_rc(tid * 16 + i * 8192, R, C); const int Rb = Epi::PERM ? ((R & ~31) + perm32(R & 31)) : R;
        voffA[i] = (unsigned)(R * K + C) * 2u; voffB[i] = (unsigned)(Rb * K + C) * 2u; }
    const size_t kstep = (size_t)(BK * 2);
    const size_t hstep = (size_t)HALF * K * 2;
    const size_t tstep = 2 * hstep;
    const unsigned ldsw = (unsigned)wid * 1024u;
    const int aoff = lds_byte(wr * 64 + fr, fq * 8), boff = lds_byte(wc * 32 + fr, fq * 8);
#define PG8_SA(b, h) (((b) * 2 + (h)) * HTB)
#define PG8_SB(b, h) ((4 + (b) * 2 + (h)) * HTB)
#define PG8_STAGE(bufoff, gbase, voff) do { _Pragma("unroll") for (int _i = 0; _i < 2; ++_i) \
        __builtin_amdgcn_global_load_lds((const unsigned*)((const char*)(gbase) + (voff)[_i]), (PG8_LAS unsigned*)(lds + (bufoff) + ldsw + _i * 8192), 16, 0, 0); } while (0)
#define PG8_LDA(dst, b, h) do { _Pragma("unroll") for (int m = 0; m < 4; ++m) _Pragma("unroll") for (int k = 0; k < 2; ++k) dst[m][k] = *(const PG8_LAS bf16x8*)(lds + PG8_SA(b, h) + aoff + m * 2048 + k * 1024); } while (0)
#define PG8_LDB(dst, b, h) do { _Pragma("unroll") for (int n = 0; n < 2; ++n) _Pragma("unroll") for (int k = 0; k < 2; ++k) dst[n][k] = *(const PG8_LAS bf16x8*)(lds + PG8_SB(b, h) + boff + n * 2048 + k * 1024); } while (0)
#define PG8_MMA(ai, bj, At, Bt) do { __builtin_amdgcn_s_setprio(1); _Pragma("unroll") for (int m = 0; m < 4; ++m) _Pragma("unroll") for (int n = 0; n < 2; ++n) _Pragma("unroll") for (int k = 0; k < 2; ++k) \
        acc[ai][bj][m][n] = __builtin_amdgcn_mfma_f32_16x16x32_bf16(Bt[n][k], At[m][k], acc[ai][bj][m][n], 0, 0, 0); __builtin_amdgcn_s_setprio(0); } while (0)
#define PG8_WAIT_V(n) asm volatile("s_waitcnt vmcnt(" #n ")" ::: "memory")
#define PG8_WAIT_L(n) asm volatile("s_waitcnt lgkmcnt(" #n ")" ::: "memory")
#define PG8_BAR __builtin_amdgcn_s_barrier()
#define PG8_SCHED __builtin_amdgcn_sched_barrier(0)
    Unit cur, nxt; int ui = 0;
    if (!S.next(0, cur)) return;
    f32x4 acc[2][2][4][2];
#pragma unroll
    for (int a = 0; a < 2; ++a)
#pragma unroll
        for (int b = 0; b < 2; ++b)
#pragma unroll
            for (int m = 0; m < 4; ++m)
#pragma unroll
                for (int n = 0; n < 2; ++n) acc[a][b][m][n] = (f32x4){0.f, 0.f, 0.f, 0.f};
    bf16x8 At[4][2], B0[2][2], B1[2][2];
    const char* cA = (const char*)g.A + (size_t)cur.pm * tstep; const char* cB = (const char*)g.Bt + (size_t)cur.pn * tstep;
    S.a_ready(cur);
    if constexpr (SP2) {
        PG8_STAGE(PG8_SB(0, 0), cB, voffB); PG8_STAGE(PG8_SB(0, 1), cB + hstep, voffB); PG8_STAGE(PG8_SA(0, 0), cA, voffA); PG8_STAGE(PG8_SA(0, 1), cA + hstep, voffA);
        if (wr == 1) PG8_BAR;
        PG8_WAIT_V(2); PG8_BAR;
        PG8_STAGE(PG8_SB(1, 0), cB + kstep, voffB); PG8_STAGE(PG8_SA(1, 0), cA + kstep, voffA); PG8_STAGE(PG8_SB(1, 1), cB + hstep + kstep, voffB);
        PG8_WAIT_V(6); PG8_BAR;
    } else {
        PG8_STAGE(PG8_SB(0, 0), cB, voffB); PG8_STAGE(PG8_SA(0, 0), cA, voffA); PG8_STAGE(PG8_SB(0, 1), cB + hstep, voffB); PG8_STAGE(PG8_SA(0, 1), cA + hstep, voffA);
        if (wr == 1) PG8_BAR;
        PG8_WAIT_V(4); PG8_BAR;
        PG8_STAGE(PG8_SB(1, 0), cB + kstep, voffB); PG8_STAGE(PG8_SA(1, 0), cA + kstep, voffA); PG8_STAGE(PG8_SB(1, 1), cB + hstep + kstep, voffB);
        PG8_WAIT_V(6); PG8_BAR;
    }
    for (;;) {
        const bool has_next = S.next(ui + 1, nxt);
        const char* nA = has_next ? (const char*)g.A + (size_t)nxt.pm * tstep : cA; const char* nB = has_next ? (const char*)g.Bt + (size_t)nxt.pn * tstep : cB;
        for (int t = 0; t < nt; t += 2) {
            const bool last = (t == nt - 2);
            const char* a1 = cA + (size_t)(t + 1) * kstep;
            const char* a2 = last ? nA : cA + (size_t)(t + 2) * kstep; const char* b2 = last ? nB : cB + (size_t)(t + 2) * kstep;
            const char* a3 = a2 + kstep; const char* b3 = b2 + kstep;
            if (last && has_next) S.a_ready(nxt);
            if constexpr (SP2) {
            PG8_LDB(B0, 0, 0); PG8_LDB(B1, 0, 1); PG8_SCHED; PG8_LDA(At, 0, 0); PG8_STAGE(PG8_SA(1, 1), a1 + hstep, voffA);
            PG8_WAIT_V(8); PG8_WAIT_L(0); PG8_BAR; PG8_MMA(0, 0, At, B0); PG8_MMA(0, 1, At, B1); PG8_BAR; PG8_SCHED;
            PG8_LDA(At, 0, 1); PG8_STAGE(PG8_SB(0, 0), b2, voffB); PG8_STAGE(PG8_SB(0, 1), b2 + hstep, voffB); PG8_STAGE(PG8_SA(0, 0), a2, voffA);
            PG8_WAIT_V(8); PG8_WAIT_L(0); PG8_BAR; PG8_MMA(1, 0, At, B0); PG8_MMA(1, 1, At, B1); PG8_BAR; PG8_SCHED;
            PG8_LDB(B0, 1, 0); PG8_LDB(B1, 1, 1); PG8_SCHED; PG8_LDA(At, 1, 0); PG8_STAGE(PG8_SA(0, 1), a2 + hstep, voffA);
            PG8_WAIT_V(8); PG8_WAIT_L(0); PG8_BAR; PG8_MMA(0, 0, At, B0); PG8_MMA(0, 1, At, B1); PG8_BAR; PG8_SCHED;
            PG8_LDA(At, 1, 1); PG8_STAGE(PG8_SB(1, 0), b3, voffB); PG8_STAGE(PG8_SB(1, 1), b3 + hstep, voffB); PG8_STAGE(PG8_SA(1, 0), a3, voffA);
            PG8_WAIT_V(8); PG8_WAIT_L(0); PG8_BAR; PG8_MMA(1, 0, At, B0); PG8_MMA(1, 1, At, B1); PG8_BAR; PG8_SCHED;
            } else {
            PG8_LDB(B0, 0, 0); PG8_SCHED; PG8_LDA(At, 0, 0); PG8_STAGE(PG8_SA(1, 1), a1 + hstep, voffA);
            PG8_WAIT_L(8); PG8_BAR; PG8_WAIT_L(0); PG8_MMA(0, 0, At, B0); PG8_BAR; PG8_SCHED;
            PG8_LDB(B1, 0, 1); PG8_STAGE(PG8_SB(0, 0), b2, voffB);
            PG8_BAR; PG8_WAIT_L(0); PG8_MMA(0, 1, At, B1); PG8_BAR;
            PG8_LDA(At, 0, 1); PG8_STAGE(PG8_SA(0, 0), a2, voffA);
            PG8_BAR; PG8_WAIT_L(0); PG8_MMA(1, 0, At, B0); PG8_BAR; PG8_SCHED;
            PG8_STAGE(PG8_SB(0, 1), b2 + hstep, voffB);
            PG8_WAIT_V(6); PG8_BAR; PG8_MMA(1, 1, At, B1); PG8_BAR;
            PG8_LDB(B0, 1, 0); PG8_SCHED; PG8_LDA(At, 1, 0); PG8_STAGE(PG8_SA(0, 1), a2 + hstep, voffA);
            PG8_WAIT_L(8); PG8_BAR; PG8_WAIT_L(0); PG8_MMA(0, 0, At, B0); PG8_BAR; PG8_SCHED;
            PG8_LDB(B1, 1, 1); PG8_STAGE(PG8_SB(1, 0), b3, voffB);
            PG8_BAR; PG8_WAIT_L(0); PG8_MMA(0, 1, At, B1); PG8_BAR;
            PG8_LDA(At, 1, 1); PG8_STAGE(PG8_SA(1, 0), a3, voffA);
            PG8_BAR; PG8_WAIT_L(0); PG8_MMA(1, 0, At, B0); PG8_BAR; PG8_SCHED;
            PG8_STAGE(PG8_SB(1, 1), b3 + hstep, voffB);
            PG8_WAIT_V(6); PG8_BAR; PG8_MMA(1, 1, At, B1); PG8_BAR;
            }
            if constexpr (Epi::HAS_MID) { E.mid(acc, cur, t + 2, wr, wc, fr, fq); }
        }
        if constexpr (ALIGN_EPI) { if (wr == 0) PG8_BAR; }
        if constexpr (!Epi::AFTER_DRAIN) { E(acc, cur, wr, wc, fr, fq); S.done(cur); }
        if (!has_next) break;
#pragma unroll
        for (int a = 0; a < 2; ++a)
#pragma unroll
            for (int b = 0; b < 2; ++b)
#pragma unroll
                for (int m = 0; m < 4; ++m)
#pragma unroll
                    for (int n = 0; n < 2; ++n) acc[a][b][m][n] = (f32x4){0.f, 0.f, 0.f, 0.f};
        cur = nxt; cA = nA; cB = nB; ++ui;
        if constexpr (ALIGN_EPI) { if (wr == 1) PG8_BAR; }
    }
    PG8_WAIT_V(0);
    if constexpr (!ALIGN_EPI) { if (wr == 0) PG8_BAR; }
    PG8_BAR;
    if constexpr (Epi::AFTER_DRAIN) { E.fused(acc, cur, wr, wc, fr, fq, lds, wid, lane); S.done(cur); }
#undef PG8_SA
#undef PG8_SB
#undef PG8_STAGE
#undef PG8_LDA
#undef PG8_LDB
#undef PG8_MMA
#undef PG8_WAIT_V
#undef PG8_WAIT_L
#undef PG8_BAR
#undef PG8_SCHED
}
}

constexpr int DM = 2048, DEPTH = 4;
constexpr int CB = 16, CL = 256, SB = 4, SL = 1024, PAST = 512;
constexpr int NCTX = CB * CL, NLAT = SB * SL, NTOK = NCTX + NLAT;
constexpr int HD = 64, SSMW = 768, SG = 48, SP = 64, SN = 16;
constexpr int WINH = 12, WINKV = 4, NAH = 12;
constexpr int DFF = 5632, NUP = 2 * DFF, NIN = 10496, KBR = 3 * SSMW;
constexpr int C_U = 0, C_QW = 768, C_KW = 1536, C_VW = 1792, C_QN = 2048, C_KN = 2816, C_VN = 3584, C_GA = 4352, C_GB = 6400, C_GC = 8448;
constexpr float QSCALE = 0.125f * 1.4426950408889634f;
constexpr size_t O_YP = 0, O_YS = O_YP + (size_t)NCTX * DM, O_WK = O_YS + (size_t)NLAT * DM;
constexpr size_t SZ_WKV = (size_t)CB * DEPTH * CL * WINKV * HD, SZ_NKV = (size_t)CB * DEPTH * CL * NAH * HD, SZ_SS = (size_t)CB * DEPTH * 2 * SG * SP;
constexpr size_t O_WV = O_WK + SZ_WKV, O_NK = O_WV + SZ_WKV, O_NV = O_NK + SZ_NKV, O_SR = O_NV + SZ_NKV, O_SI = O_SR + SZ_SS, O_END = O_SI + SZ_SS;

constexpr size_t MiB = 1u << 20;
constexpr size_t WS_CTL = 0, CTL_ZERO_BYTES = 1 * MiB;
constexpr size_t WS_MOD = 1 * MiB;
constexpr size_t WS_MODP = 2 * MiB;
constexpr size_t WS_SSMT = 18 * MiB;
constexpr size_t SSMT_LAM = 0, SSMT_BB = 256 * 1024;
constexpr size_t WS_ROPE = 23 * MiB;
constexpr size_t WS_W = 24 * MiB;
constexpr size_t LW_IN = 0, LW_GLU = LW_IN + (size_t)NIN * DM * 2, LW_BR = LW_GLU + (size_t)SSMW * SSMW * 2, LW_OUT = LW_BR + (size_t)DM * KBR * 2,
                 LW_UP = LW_OUT + (size_t)DM * DM * 2, LW_DN = LW_UP + (size_t)NUP * DM * 2, LW_BYTES = LW_DN + (size_t)DM * DFF * 2;
constexpr size_t WS_X = WS_W + 4 * LW_BYTES + MiB - (4 * LW_BYTES) % MiB;
constexpr size_t WS_H = WS_X + (size_t)NTOK * DM * 4;
constexpr size_t WS_PU = WS_H + (size_t)NTOK * DM * 2;
constexpr size_t WS_YF = WS_PU + (size_t)NTOK * NUP * 2;
constexpr size_t WS_YG = WS_YF + (size_t)2 * NTOK * SSMW * 4;
constexpr size_t WS_OC = WS_YG + (size_t)NTOK * SSMW * 2;
constexpr size_t WS_MB = WS_OC + (size_t)NTOK * KBR * 2;
constexpr size_t WS_ACT = WS_MB + (size_t)NTOK * DM * 2;
constexpr size_t WS_END = WS_ACT + (size_t)NTOK * DFF * 2;
constexpr int CW_TMO = 0, CW_BAR = 4096;

constexpr int NWAVES = 8;
constexpr int RING_OFF = 0, RING_BYTES = 131072, LDSCTL_OFF = RING_BYTES, MISC_OFF = LDSCTL_OFF + 320, LDS_BYTES = 147456;

#define GAS __attribute__((address_space(1)))
#define LAS __attribute__((address_space(3)))
typedef unsigned short bf16;
typedef unsigned v4u __attribute__((ext_vector_type(4)));
typedef unsigned v2u __attribute__((ext_vector_type(2)));
typedef float f32x4 __attribute__((ext_vector_type(4)));
typedef GAS unsigned gu32;
#define RLX_AGENT __ATOMIC_RELAXED, __HIP_MEMORY_SCOPE_AGENT
#define LDS_WAIT() asm volatile("s_waitcnt lgkmcnt(0)" ::: "memory")
#define VM_WAIT() asm volatile("s_waitcnt vmcnt(0)" ::: "memory")
__device__ __forceinline__ unsigned f2bf(float f) { unsigned u = __builtin_bit_cast(unsigned, f); return (u + 0x7fffu + ((u >> 16) & 1u)) >> 16; }
__device__ __forceinline__ unsigned pk2(float lo, float hi) { return f2bf(lo) | (f2bf(hi) << 16); }
__device__ __forceinline__ float bflo(unsigned u) { return __uint_as_float(u << 16); }
__device__ __forceinline__ float bfhi(unsigned u) { return __uint_as_float(u & 0xffff0000u); }
__device__ __forceinline__ float bf2f(bf16 h) { return __uint_as_float((unsigned)h << 16); }
__device__ __forceinline__ float fexp(float x) { return __builtin_amdgcn_exp2f(x * 1.4426950408889634f); }
__device__ __forceinline__ float frcp(float x) { return __builtin_amdgcn_rcpf(x); }
__device__ __forceinline__ float sigm(float x) { return frcp(1.f + fexp(fminf(-x, 80.f))); }
__device__ __forceinline__ float gelu_tanh(float x) { const float u = 0.7978845608028654f * (x + 0.044715f * x * x * x); return x * frcp(1.f + fexp(fminf(-2.f * u, 80.f))); }
__device__ __forceinline__ int cond_of(int tok) { return tok < NCTX ? 0 : 1 + ((tok - NCTX) >> 10); }

#define XB_TMO      128
#define XB_XCNT(j)  (256  + 64 * (j))
#define XB_XSUB(j)  (1280 + 64 * (j))
#define XB_XGEN(j)  (2304 + 64 * (j))
#define XB_TOP      3328
#define XB_TOPGEN   3392
#define XCD_BAR_WORDS 3456
#define XB_SPIN_CAP (1u << 18)

__device__ __forceinline__ unsigned xb_ld(unsigned* p)              { return __hip_atomic_load(p, __ATOMIC_RELAXED, __HIP_MEMORY_SCOPE_AGENT); }
__device__ __forceinline__ unsigned xb_add(unsigned* p, unsigned v) { return __hip_atomic_fetch_add(p, v, __ATOMIC_RELAXED, __HIP_MEMORY_SCOPE_AGENT); }
__device__ __forceinline__ unsigned xb_xcc_id() { return (unsigned)__builtin_amdgcn_s_getreg((3 << 11) | 20) & 0xFu; }
#define XB_SPIN(cond, bar) do { unsigned _sp = 0; while (cond) { __builtin_amdgcn_s_sleep(1); \
    if ((++_sp & 255u) == 0u) { if (xb_ld(&(bar)[XB_TMO])) break; if (_sp > XB_SPIN_CAP) { atomicAdd(&(bar)[XB_TMO], 1u); break; } } } } while (0)

struct XcdBarrier {
    unsigned* bar; unsigned x;
    volatile LAS unsigned* st;
};

__device__ __forceinline__ XcdBarrier xcd_barrier_post(unsigned* bar, volatile LAS unsigned* st) {
    XcdBarrier b; b.bar = bar; b.x = xb_xcc_id(); b.st = st;
    if (threadIdx.x == 0) (void)xb_add(&bar[XB_XCNT(b.x)], 1u);
    return b;
}
__device__ __forceinline__ void xcd_barrier_complete(unsigned* bar, unsigned x, unsigned& nloc, unsigned& nx) {
    const unsigned G = gridDim.x * gridDim.y * gridDim.z;
    unsigned sum, cnt, mine, sp = 0u;
    for (;;) {
        sum = 0u; cnt = 0u; mine = 0u;
#pragma unroll
        for (unsigned j = 0; j < 16; ++j) { const unsigned c = xb_ld(&bar[XB_XCNT(j)]); sum += c; cnt += (c > 0u) ? 1u : 0u; mine = (j == x) ? c : mine; }
        if (sum == G) break;
        __builtin_amdgcn_s_sleep(1);
        if ((++sp & 255u) == 0u) { if (xb_ld(&bar[XB_TMO])) break; if (sp > XB_SPIN_CAP) { atomicAdd(&bar[XB_TMO], 1u); break; } }
    }
    nloc = mine > 0u ? mine : 1u; nx = cnt > 0u ? cnt : 1u;
}

__device__ __forceinline__ void xcd_barrier(const XcdBarrier& b) {
    asm volatile("s_waitcnt vmcnt(0)" ::: "memory");
    __syncthreads();
    if (threadIdx.x == 0) {
        unsigned* bar = b.bar;
        __builtin_amdgcn_s_waitcnt(0);
        unsigned nloc = b.st[0], nx = b.st[1];
        if (nloc == 0u) { xcd_barrier_complete(bar, b.x, nloc, nx); b.st[0] = nloc; b.st[1] = nx; }
        const unsigned old = xb_add(&bar[XB_XSUB(b.x)], 1u);
        const unsigned gen = old / nloc;
        if (old + 1u == (gen + 1u) * nloc) {
            __builtin_amdgcn_fence(__ATOMIC_RELEASE, "agent");
            asm volatile("s_waitcnt vmcnt(0)" ::: "memory");
            const unsigned og = xb_add(&bar[XB_TOP], 1u);
            const unsigned tg = og / nx;
            if (og + 1u == (tg + 1u) * nx) xb_add(&bar[XB_TOPGEN], 1u);
            else XB_SPIN(xb_ld(&bar[XB_TOPGEN]) == tg, bar);
            __builtin_amdgcn_fence(__ATOMIC_ACQUIRE, "agent");
            xb_add(&bar[XB_XGEN(b.x)], 1u);
            asm volatile("s_waitcnt vmcnt(0)" ::: "memory");
        } else {
            XB_SPIN(xb_ld(&bar[XB_XGEN(b.x)]) == gen, bar);
            __builtin_amdgcn_fence(__ATOMIC_ACQUIRE, "agent");
            asm volatile("s_waitcnt vmcnt(0)" ::: "memory");
        }
    }
    __syncthreads();
}

struct Args { const float* in[34]; float* out; unsigned char* ws; int ph_lo, ph_hi; };
struct Frame {
    LAS unsigned char* lds; volatile LAS unsigned* MISC; gu32* ctl;
    int G;
    float* out; unsigned char* ws;
};
#define IN_(k) (A.in[k])
enum { I_XP = 0, I_XS, I_CWK, I_CWV, I_CNK, I_CNV, I_STRE, I_STIM, I_C, I_CCTX, I_N1G, I_N2G, I_WMOD, I_BMOD, I_WIN, I_LAMRE, I_LAMIM, I_LOGDT, I_BRE, I_BIM, I_CRE, I_CIM,
       I_SSMD, I_WGLU, I_BGLU, I_SINK, I_RPB, I_WBR, I_WOUT, I_WUP, I_CONVW, I_CONVB, I_WDN, I_FING };

#define PHASE_IDS() int tid = threadIdx.x; asm volatile("" : "+v"(tid)); const int lane = tid & 63, wave = __builtin_amdgcn_readfirstlane(tid >> 6), gw = blockIdx.x * NWAVES + wave, ngw = F.G * NWAVES; (void)lane; (void)gw; (void)ngw
__device__ __forceinline__ float wave_sum(float v) {
#pragma unroll
    for (int o = 1; o < 64; o <<= 1) v += __shfl_xor(v, o);
    return v;
}

using pg8::Unit;
struct EpiInProj {
    static constexpr bool PERM = true, AFTER_DRAIN = false, HAS_MID = false;
    bf16* P; float* out; const float* rope; int layer;
    __device__ __forceinline__ void mid(f32x4 (&)[2][2][4][2], const Unit&, int, int, int, int, int) const {}
    __device__ __forceinline__ void operator()(const f32x4 (&acc)[2][2][4][2], const Unit& u, int wr, int wc, int fr, int fq) const {
        const int row0 = u.pm * 256 + wr * 64 + fr, colt = wc * 32 + 8 * fq, pn = u.pn;
        const bool lat = u.pm >= CB;
        const bool do_rope = lat && pn >= 3 && pn <= 6;
        const float qs = ((pn >= 3 && pn <= 5) || (pn >= 8 && pn <= 10)) ? QSCALE : 1.f;
        float* obase = nullptr; int ow = 0, ocol = 0;
        if (!lat) { if (pn == 6) { obase = out + O_WK; ow = 256; } else if (pn == 7) { obase = out + O_WV; ow = 256; }
                    else if (pn >= 11 && pn <= 13) { obase = out + O_NK; ow = 768; ocol = (pn - 11) * 256; } else if (pn >= 14 && pn <= 16) { obase = out + O_NV; ow = 768; ocol = (pn - 14) * 256; } }
        const float sgn = fq < 2 ? -1.f : 1.f; const int i0 = 8 * (fq & 1);
#pragma unroll
        for (int ai = 0; ai < 2; ++ai)
#pragma unroll
            for (int m = 0; m < 4; ++m) { const int row = row0 + ai * 128 + m * 16;
                f32x4 cs0 = {1.f, 1.f, 1.f, 1.f}, cs1 = cs0, sn0 = {0.f, 0.f, 0.f, 0.f}, sn1 = sn0;
                if (do_rope) { const int pos = (row - NCTX) & (SL - 1); const int comp = (wc & 1) ? (pos & 63) : (pos >> 6); const float* rt = rope + comp * 32 + i0;
                    cs0 = *(const f32x4*)(rt); cs1 = *(const f32x4*)(rt + 4); sn0 = *(const f32x4*)(rt + 16); sn1 = *(const f32x4*)(rt + 20); }
                bf16* prow = P + (size_t)row * NIN + pn * 256 + colt;
#pragma unroll
                for (int bj = 0; bj < 2; ++bj) { f32x4 v0 = acc[ai][bj][m][0], v1 = acc[ai][bj][m][1];
                    if (obase) { float* o = obase + ((size_t)(u.pm * DEPTH + layer) * CL + (row & 255)) * ow + ocol + colt + bj * 128; *(f32x4*)o = v0; *(f32x4*)(o + 4) = v1; }
                    if (do_rope) { f32x4 p0, p1;
#pragma unroll
                        for (int e = 0; e < 4; ++e) { p0[e] = __shfl_xor(v0[e], 32); p1[e] = __shfl_xor(v1[e], 32); }
                        v0 = v0 * cs0 + (p0 * sgn) * sn0; v1 = v1 * cs1 + (p1 * sgn) * sn1; }
                    v0 = v0 * qs; v1 = v1 * qs;
                    v4u w; w.x = pg8::cvt_pk_bf16(v0[0], v0[1]); w.y = pg8::cvt_pk_bf16(v0[2], v0[3]); w.z = pg8::cvt_pk_bf16(v1[0], v1[1]); w.w = pg8::cvt_pk_bf16(v1[2], v1[3]);
                    *(v4u*)(prow + bj * 128) = w; } }
    }
};
struct EpiBf16Plain {
    static constexpr bool PERM = true, AFTER_DRAIN = false, HAS_MID = false;
    bf16* O; int ldc;
    __device__ __forceinline__ void mid(f32x4 (&)[2][2][4][2], const Unit&, int, int, int, int, int) const {}
    __device__ __forceinline__ void operator()(const f32x4 (&acc)[2][2][4][2], const Unit& u, int wr, int wc, int fr, int fq) const {
        const int row0 = u.pm * 256 + wr * 64 + fr, col0 = u.pn * 256 + wc * 32 + 8 * fq;
#pragma unroll
        for (int ai = 0; ai < 2; ++ai)
#pragma unroll
            for (int m = 0; m < 4; ++m) { bf16* rowp = O + (size_t)(row0 + ai * 128 + m * 16) * ldc + col0;
#pragma unroll
                for (int bj = 0; bj < 2; ++bj) { const f32x4 v0 = acc[ai][bj][m][0], v1 = acc[ai][bj][m][1];
                    v4u w; w.x = pg8::cvt_pk_bf16(v0[0], v0[1]); w.y = pg8::cvt_pk_bf16(v0[2], v0[3]); w.z = pg8::cvt_pk_bf16(v1[0], v1[1]); w.w = pg8::cvt_pk_bf16(v1[2], v1[3]);
                    *(v4u*)(rowp + bj * 128) = w; } }
    }
};
struct EpiGlu {
    static constexpr bool PERM = true, AFTER_DRAIN = false, HAS_MID = false;
    const bf16* Y; bf16* O; const float* bias;
    __device__ __forceinline__ void mid(f32x4 (&)[2][2][4][2], const Unit&, int, int, int, int, int) const {}
    __device__ __forceinline__ void operator()(const f32x4 (&acc)[2][2][4][2], const Unit& u, int wr, int wc, int fr, int fq) const {
        const int row0 = u.pm * 256 + wr * 64 + fr, col0 = u.pn * 256 + wc * 32 + 8 * fq;
        f32x4 bv[2][2];
#pragma unroll
        for (int bj = 0; bj < 2; ++bj) { bv[bj][0] = *(const f32x4*)(bias + col0 + bj * 128); bv[bj][1] = *(const f32x4*)(bias + col0 + bj * 128 + 4); }
#pragma unroll
        for (int ai = 0; ai < 2; ++ai)
#pragma unroll
            for (int m = 0; m < 4; ++m) { const size_t row = row0 + ai * 128 + m * 16;
#pragma unroll
                for (int bj = 0; bj < 2; ++bj) { const v4u y = *(const v4u*)(Y + row * SSMW + col0 + bj * 128);
                    const f32x4 v0 = acc[ai][bj][m][0] + bv[bj][0], v1 = acc[ai][bj][m][1] + bv[bj][1];
                    v4u w; w.x = pg8::cvt_pk_bf16(bflo(y.x) * sigm(v0[0]), bfhi(y.x) * sigm(v0[1])); w.y = pg8::cvt_pk_bf16(bflo(y.y) * sigm(v0[2]), bfhi(y.y) * sigm(v0[3]));
                    w.z = pg8::cvt_pk_bf16(bflo(y.z) * sigm(v1[0]), bfhi(y.z) * sigm(v1[1])); w.w = pg8::cvt_pk_bf16(bflo(y.w) * sigm(v1[2]), bfhi(y.w) * sigm(v1[3]));
                    *(v4u*)(O + row * KBR + col0 + bj * 128) = w; } }
    }
};
struct EpiBranch {
    static constexpr bool PERM = true, AFTER_DRAIN = false, HAS_MID = true;
    const bf16* P; bf16* M;
    __device__ __forceinline__ void mid(f32x4 (&acc)[2][2][4][2], const Unit& u, int tnext, int wr, int wc, int fr, int fq) const {
        if (tnext != 12 && tnext != 24) return;
        asm volatile("" : "+v"(fr), "+v"(fq));
        const int cnum = tnext == 12 ? C_GA : C_GB, cden = tnext == 12 ? C_GB : C_GC;
        const int row0 = u.pm * 256 + wr * 64 + fr, col0 = u.pn * 256 + wc * 32 + 8 * fq;
#pragma unroll
        for (int ai = 0; ai < 2; ++ai)
#pragma unroll
            for (int m = 0; m < 4; ++m) { const bf16* prow = P + (size_t)(row0 + ai * 128 + m * 16) * NIN + col0;
#pragma unroll
                for (int bj = 0; bj < 2; ++bj) { const v4u a = *(const v4u*)(prow + cnum + bj * 128), b = *(const v4u*)(prow + cden + bj * 128);
#define RAT(x, y) ((1.f + fexp(fminf(-(y), 80.f))) * frcp(1.f + fexp(fminf(-(x), 80.f))))
                    f32x4 r0, r1; r0[0] = RAT(bflo(a.x), bflo(b.x)); r0[1] = RAT(bfhi(a.x), bfhi(b.x)); r0[2] = RAT(bflo(a.y), bflo(b.y)); r0[3] = RAT(bfhi(a.y), bfhi(b.y));
                    r1[0] = RAT(bflo(a.z), bflo(b.z)); r1[1] = RAT(bfhi(a.z), bfhi(b.z)); r1[2] = RAT(bflo(a.w), bflo(b.w)); r1[3] = RAT(bfhi(a.w), bfhi(b.w));
#undef RAT
                    acc[ai][bj][m][0] = acc[ai][bj][m][0] * r0; acc[ai][bj][m][1] = acc[ai][bj][m][1] * r1; } }
    }
    __device__ __forceinline__ void operator()(const f32x4 (&acc)[2][2][4][2], const Unit& u, int wr, int wc, int fr, int fq) const {
        const int row0 = u.pm * 256 + wr * 64 + fr, col0 = u.pn * 256 + wc * 32 + 8 * fq;
#pragma unroll
        for (int ai = 0; ai < 2; ++ai)
#pragma unroll
            for (int m = 0; m < 4; ++m) { const size_t row = row0 + ai * 128 + m * 16;
#pragma unroll
                for (int bj = 0; bj < 2; ++bj) { const v4u g = *(const v4u*)(P + row * NIN + C_GC + col0 + bj * 128);
                    const f32x4 v0 = acc[ai][bj][m][0], v1 = acc[ai][bj][m][1];
                    v4u w; w.x = pg8::cvt_pk_bf16(v0[0] * sigm(bflo(g.x)), v0[1] * sigm(bfhi(g.x))); w.y = pg8::cvt_pk_bf16(v0[2] * sigm(bflo(g.y)), v0[3] * sigm(bfhi(g.y)));
                    w.z = pg8::cvt_pk_bf16(v1[0] * sigm(bflo(g.z)), v1[1] * sigm(bfhi(g.z))); w.w = pg8::cvt_pk_bf16(v1[2] * sigm(bflo(g.w)), v1[3] * sigm(bfhi(g.w)));
                    *(v4u*)(M + row * DM + col0 + bj * 128) = w; } }
    }
};
struct EpiResid {
    static constexpr bool PERM = false, AFTER_DRAIN = false, HAS_MID = false;
    const float* xa; const float* xb; float* X; const float* gate;
    __device__ __forceinline__ void mid(f32x4 (&)[2][2][4][2], const Unit&, int, int, int, int, int) const {}
    __device__ __forceinline__ void operator()(const f32x4 (&acc)[2][2][4][2], const Unit& u, int wr, int wc, int fr, int fq) const {
        const int row0 = u.pm * 256 + wr * 64 + fr, col0 = u.pn * 256 + wc * 32 + 4 * fq;
        const float* src = u.pm < CB ? xa : xb - (size_t)NCTX * DM;
        const float* gt = gate + (size_t)cond_of(u.pm * 256) * 6 * DM + col0;
        f32x4 gv[2][2];
#pragma unroll
        for (int bj = 0; bj < 2; ++bj)
#pragma unroll
            for (int n = 0; n < 2; ++n) gv[bj][n] = *(const f32x4*)(gt + bj * 128 + n * 16);
#pragma unroll
        for (int ai = 0; ai < 2; ++ai)
#pragma unroll
            for (int m = 0; m < 4; ++m) { const size_t off = (size_t)(row0 + ai * 128 + m * 16) * DM + col0;
#pragma unroll
                for (int bj = 0; bj < 2; ++bj)
#pragma unroll
                    for (int n = 0; n < 2; ++n) { const f32x4 xs = *(const f32x4*)(src + off + bj * 128 + n * 16); *(f32x4*)(X + off + bj * 128 + n * 16) = xs + gv[bj][n] * acc[ai][bj][m][n]; } }
    }
};

__device__ __forceinline__ void p0_transpose_item(const float* W, int K, int N, bf16* WT, LAS float* scr, int item, int lane) {
    const int nblk = N / 32, kb = item / nblk, nb = item % nblk, k0 = 64 * kb, n0 = 32 * nb;
#pragma unroll 8
    for (int i = 0; i < 32; ++i) { const int kk = 2 * i + (lane >> 5); scr[kk * 33 + (lane & 31)] = W[(size_t)(k0 + kk) * N + n0 + (lane & 31)]; }
    LDS_WAIT(); asm volatile("" ::: "memory");
    const int c = lane & 7;
#pragma unroll
    for (int j = 0; j < 4; ++j) { const int n = (lane >> 3) + 8 * j; const LAS float* s = scr + (8 * c) * 33 + n;
        v4u o; o.x = pk2(s[0 * 33], s[1 * 33]); o.y = pk2(s[2 * 33], s[3 * 33]); o.z = pk2(s[4 * 33], s[5 * 33]); o.w = pk2(s[6 * 33], s[7 * 33]);
        *(GAS v4u*)(WT + (size_t)(n0 + n) * K + k0 + 8 * c) = o; }
    LDS_WAIT(); asm volatile("" ::: "memory");
}
__device__ __forceinline__ void sincos_f(float x, float& s, float& c) {
    const float k = rintf(x * 0.63661977236758134f);
    float r = fmaf(k, -1.5707962512969971f, x); r = fmaf(k, -7.5497894158615964e-08f, r); r = fmaf(k, -5.3903025299577648e-15f, r);
    const float r2 = r * r;
    const float sp = r * (1.f + r2 * (-1.6666667163e-01f + r2 * (8.3333337680e-03f + r2 * (-1.9841270114e-04f + r2 * (2.7557314297e-06f + r2 * (-2.5050759689e-08f))))));
    const float cp = 1.f + r2 * (-0.5f + r2 * (4.1666667908e-02f + r2 * (-1.3888889225e-03f + r2 * (2.4801587642e-05f + r2 * (-2.7557314297e-07f + r2 * 2.0876756e-09f)))));
    const int q = ((int)k) & 3;
    s = (q == 0) ? sp : (q == 1) ? cp : (q == 2) ? -sp : -cp;
    c = (q == 0) ? cp : (q == 1) ? -sp : (q == 2) ? -cp : sp;
}

__device__ __forceinline__ void phase_prologue(const Args& A, Frame& F) {
    PHASE_IDS();
    LAS float* scr = (LAS float*)(F.lds + RING_OFF + wave * 16384);
    {
        constexpr int I_IN = (DM / 64) * (NIN / 32), I_GL = (SSMW / 64) * (SSMW / 32), I_BR = (KBR / 64) * (DM / 32), I_OU = (DM / 64) * (DM / 32), I_UP = (DM / 64) * (NUP / 32), I_DN = (DFF / 64) * (DM / 32);
        constexpr int PER_L = I_IN + I_GL + I_BR + I_OU + I_UP + I_DN;
        for (int it = gw; it < DEPTH * PER_L; it += ngw) {
            const int l = it / PER_L; int r = it % PER_L; unsigned char* wl = F.ws + WS_W + (size_t)l * LW_BYTES;
            if (r < I_IN) { p0_transpose_item(IN_(I_WIN) + (size_t)l * DM * NIN, DM, NIN, (bf16*)(wl + LW_IN), scr, r, lane); continue; } r -= I_IN;
            if (r < I_GL) { p0_transpose_item(IN_(I_WGLU) + (size_t)l * SSMW * SSMW, SSMW, SSMW, (bf16*)(wl + LW_GLU), scr, r, lane); continue; } r -= I_GL;
            if (r < I_BR) { p0_transpose_item(IN_(I_WBR) + (size_t)l * KBR * DM, KBR, DM, (bf16*)(wl + LW_BR), scr, r, lane); continue; } r -= I_BR;
            if (r < I_OU) { p0_transpose_item(IN_(I_WOUT) + (size_t)l * DM * DM, DM, DM, (bf16*)(wl + LW_OUT), scr, r, lane); continue; } r -= I_OU;
            if (r < I_UP) { p0_transpose_item(IN_(I_WUP) + (size_t)l * DM * NUP, DM, NUP, (bf16*)(wl + LW_UP), scr, r, lane); continue; } r -= I_UP;
            p0_transpose_item(IN_(I_WDN) + (size_t)l * DFF * DM, DFF, DM, (bf16*)(wl + LW_DN), scr, r, lane);
        }
    }
    __syncthreads();
    {
        LAS float* sc = (LAS float*)(F.lds + RING_OFF);
        float* modp = (float*)(F.ws + WS_MODP);
        for (int task = blockIdx.x; task < DEPTH * 24 * 16; task += F.G) {
            const int ks = task & 15, cg = (task >> 4) % 24, l = task / (16 * 24);
            __syncthreads();
            for (int i = tid; i < 5 * 128; i += NWAVES * 64) { const int j = i >> 7, k = ks * 128 + (i & 127); const float v = j == 0 ? IN_(I_CCTX)[k] : IN_(I_C)[(j - 1) * DM + k]; sc[i] = v * sigm(v); }
            __syncthreads();
            const int n = cg * 512 + tid; const float* W = IN_(I_WMOD) + ((size_t)l * DM + ks * 128) * (6 * DM) + n;
            float a0 = 0.f, a1 = 0.f, a2 = 0.f, a3 = 0.f, a4 = 0.f;
#pragma unroll 8
            for (int k = 0; k < 128; ++k) { const float w = W[(size_t)k * (6 * DM)]; a0 += sc[k] * w; a1 += sc[128 + k] * w; a2 += sc[256 + k] * w; a3 += sc[384 + k] * w; a4 += sc[512 + k] * w; }
            float* o = modp + (((size_t)ks * DEPTH + l) * 5) * (6 * DM) + n;
            o[0] = a0; o[6 * DM] = a1; o[12 * DM] = a2; o[18 * DM] = a3; o[24 * DM] = a4;
        }
    }
    {
        const int gt = blockIdx.x * (NWAVES * 64) + tid, ngt = F.G * NWAVES * 64;
        float* lamt = (float*)(F.ws + WS_SSMT + SSMT_LAM); float* bbt = (float*)(F.ws + WS_SSMT + SSMT_BB);
        for (int i = gt; i < DEPTH * 2 * SG * SP; i += ngt) {
            const float lr = IN_(I_LAMRE)[i], li = IN_(I_LAMIM)[i], dt = expf(IN_(I_LOGDT)[i / SP]);
            float sn, cs; sincos_f(li * dt, sn, cs);
            const float er = expf(lr * dt), lbr = er * cs, lbi = er * sn;
            const float nr = lbr - 1.f, ni = lbi, den = lr * lr + li * li, cr = (nr * lr + ni * li) / den, ci = (ni * lr - nr * li) / den;
            lamt[2 * i] = lbr; lamt[2 * i + 1] = lbi;
            for (int n = 0; n < SN; ++n) { const float br = IN_(I_BRE)[(size_t)i * SN + n], bi = IN_(I_BIM)[(size_t)i * SN + n]; bbt[((size_t)i * SN + n) * 2] = cr * br - ci * bi; bbt[((size_t)i * SN + n) * 2 + 1] = cr * bi + ci * br; }
        }
        float* rope = (float*)(F.ws + WS_ROPE);
        for (int i = gt; i < 64 * 16; i += ngt) { const int comp = i >> 4, f = i & 15; const float inv = exp2f(-(float)f * (13.287712379549449f / 16.f)); float sn, cs; sincos_f((float)comp * inv, sn, cs); rope[comp * 32 + f] = cs; rope[comp * 32 + 16 + f] = sn; }
    }
}
__device__ __forceinline__ void phase_mod_reduce(const Args& A, Frame& F) {
    PHASE_IDS();
    const int gt = blockIdx.x * (NWAVES * 64) + tid, ngt = F.G * NWAVES * 64;
    const float* modp = (const float*)(F.ws + WS_MODP); float* mod = (float*)(F.ws + WS_MOD);
    for (int i = gt; i < DEPTH * 5 * 6 * DM; i += ngt) { const int n = i % (6 * DM), l = i / (5 * 6 * DM); float a = IN_(I_BMOD)[l * 6 * DM + n];
#pragma unroll
        for (int ks = 0; ks < 16; ++ks) a += modp[(size_t)ks * DEPTH * 5 * 6 * DM + i];
        mod[i] = a; }
}
__device__ __forceinline__ void phase_norm(Frame& F, const float* xa, const float* xb, const float* g, const float* mod_l, int s_shift, int s_scale, bf16* H) {
    PHASE_IDS();
    for (int row = gw; row < NTOK; row += ngw) {
        const float* xr = row < NCTX ? xa + (size_t)row * DM : xb + (size_t)(row - NCTX) * DM;
        f32x4 v[8]; float ss = 0.f;
#pragma unroll
        for (int j = 0; j < 8; ++j) { v[j] = *(const f32x4*)(xr + 4 * lane + 256 * j); ss += (v[j].x * v[j].x + v[j].y * v[j].y) + (v[j].z * v[j].z + v[j].w * v[j].w); }
        const float r = 1.0f / sqrtf(wave_sum(ss) * (1.f / DM) + 1e-6f);
        const float* m = mod_l + (size_t)cond_of(row) * 6 * DM;
#pragma unroll
        for (int j = 0; j < 8; ++j) { const int c = 4 * lane + 256 * j; const f32x4 gg = *(const f32x4*)(g + c), sc = *(const f32x4*)(m + s_scale * DM + c), sh = *(const f32x4*)(m + s_shift * DM + c);
            const f32x4 y = v[j] * r * gg * (sc + 1.f) + sh; v2u w; w.x = pk2(y.x, y.y); w.y = pk2(y.z, y.w); *(v2u*)(H + (size_t)row * DM + c) = w; }
    }
}
__device__ __forceinline__ void phase_final_norm(Frame& F, const float* X, const float* g, float* out) {
    PHASE_IDS();
    for (int row = gw; row < NTOK; row += ngw) {
        const float* xr = X + (size_t)row * DM;
        f32x4 v[8]; float ss = 0.f;
#pragma unroll
        for (int j = 0; j < 8; ++j) { v[j] = *(const f32x4*)(xr + 4 * lane + 256 * j); ss += (v[j].x * v[j].x + v[j].y * v[j].y) + (v[j].z * v[j].z + v[j].w * v[j].w); }
        const float r = 1.0f / sqrtf(wave_sum(ss) * (1.f / DM) + 1e-6f);
#pragma unroll
        for (int j = 0; j < 8; ++j) { const int c = 4 * lane + 256 * j; *(f32x4*)(out + (size_t)row * DM + c) = v[j] * r * *(const f32x4*)(g + c); }
    }
}
__device__ __forceinline__ void phase_conv_act(Frame& F, const bf16* U, const float* cw, const float* cb, bf16* act) {
    PHASE_IDS();
    constexpr int NCC = DFF / 256;
    for (int task = gw; task < (NTOK / 16) * NCC; task += ngw) {
        const int rb = task / NCC, cc = task % NCC, t0 = rb * 16, j0 = cc * 256 + 4 * lane;
        const int pos0 = t0 < NCTX ? (t0 & (CL - 1)) : ((t0 - NCTX) & (SL - 1)), L = t0 < NCTX ? CL : SL;
        const f32x4 wa0 = *(const f32x4*)(cw + j0), wa1 = *(const f32x4*)(cw + NUP + j0), wa2 = *(const f32x4*)(cw + 2 * NUP + j0), ba = *(const f32x4*)(cb + j0);
        const f32x4 wb0 = *(const f32x4*)(cw + DFF + j0), wb1 = *(const f32x4*)(cw + NUP + DFF + j0), wb2 = *(const f32x4*)(cw + 2 * NUP + DFF + j0), bb = *(const f32x4*)(cb + DFF + j0);
        const bf16* up = U + (size_t)t0 * NUP + j0;
        auto ld = [&](const bf16* p) { const v2u w = *(const v2u*)p; f32x4 r; r.x = bflo(w.x); r.y = bfhi(w.x); r.z = bflo(w.y); r.w = bfhi(w.y); return r; };
        const f32x4 z = {0.f, 0.f, 0.f, 0.f};
        f32x4 ap = pos0 > 0 ? ld(up - NUP) : z, bp = pos0 > 0 ? ld(up - NUP + DFF) : z, ac = ld(up), bc = ld(up + DFF);
#pragma unroll 4
        for (int r = 0; r < 16; ++r) {
            const bool hn = pos0 + r + 1 < L;
            const f32x4 an = hn ? ld(up + (size_t)(r + 1) * NUP) : z, bn = hn ? ld(up + (size_t)(r + 1) * NUP + DFF) : z;
            const f32x4 a = ba + wa0 * ap + wa1 * ac + wa2 * an, b = bb + wb0 * bp + wb1 * bc + wb2 * bn;
            v2u w; w.x = pk2(a.x * sigm(a.x) * b.x, a.y * sigm(a.y) * b.y); w.y = pk2(a.z * sigm(a.z) * b.z, a.w * sigm(a.w) * b.w);
            *(v2u*)(act + (size_t)(t0 + r) * DFF + j0) = w;
            ap = ac; bp = bc; ac = an; bc = bn;
        }
    }
}
__device__ __forceinline__ void phase_ssm_post(Frame& F, const bf16* P, const float* Ypart, const float* dskip, bf16* Yg) {
    PHASE_IDS();
    for (int row = gw; row < NTOK; row += ngw) {
#pragma unroll
        for (int j = 0; j < 3; ++j) { const int c = 4 * lane + 256 * j;
            const f32x4 yf = *(const f32x4*)(Ypart + (size_t)row * SSMW + c), yb = *(const f32x4*)(Ypart + ((size_t)NTOK + row) * SSMW + c), d = *(const f32x4*)(dskip + c);
            const v2u uw = *(const v2u*)(P + (size_t)row * NIN + C_U + c);
            f32x4 y; y.x = yf.x + yb.x + d.x * bflo(uw.x); y.y = yf.y + yb.y + d.y * bfhi(uw.x); y.z = yf.z + yb.z + d.z * bflo(uw.y); y.w = yf.w + yb.w + d.w * bfhi(uw.y);
            v2u w; w.x = pk2(gelu_tanh(y.x), gelu_tanh(y.y)); w.y = pk2(gelu_tanh(y.z), gelu_tanh(y.w)); *(v2u*)(Yg + (size_t)row * SSMW + c) = w; }
    }
}

__device__ __forceinline__ void phase_ssm(const Args& A, Frame& F, const bf16* P, int l, float* Ypart) {
    PHASE_IDS();
    LAS float* wl = (LAS float*)(F.lds + RING_OFF + wave * 16384);
    LAS float* cre = wl; LAS float* cim = wl + 1024; LAS float* xr = wl + 2048; LAS float* xi = wl + 3072;
    const float* lamt = (const float*)(F.ws + WS_SSMT + SSMT_LAM); const float* bbt = (const float*)(F.ws + WS_SSMT + SSMT_BB);
    const int p = lane;
    for (int unit = gw; unit < (CB + SB) * SG * 2; unit += ngw) {
        const int dir = unit & 1, g = (unit >> 1) % SG; int bb = unit / (2 * SG); bb = bb < SB ? CB + bb : bb - SB;
        const bool ctx = bb < CB; const int base = ctx ? bb * CL : NCTX + (bb - CB) * SL, L = ctx ? CL : SL;
        const size_t pi = (((size_t)l * 2 + dir) * SG + g) * SP + p;
        const float ar = lamt[2 * pi], ai = lamt[2 * pi + 1];
        float bbr[SN], bbi[SN];
#pragma unroll
        for (int n = 0; n < SN; n += 2) { const f32x4 t = *(const f32x4*)(bbt + (pi * SN + n) * 2); bbr[n] = t.x; bbi[n] = t.y; bbr[n + 1] = t.z; bbi[n + 1] = t.w; }
#pragma unroll
        for (int n = 0; n < SN; ++n) { const size_t ci_ = ((((size_t)l * 2 + dir) * SG + g) * SN + n) * SP + p; cre[n * 64 + p] = IN_(I_CRE)[ci_]; cim[n * 64 + p] = IN_(I_CIM)[ci_]; }
        float sr = 0.f, si = 0.f;
        if (!ctx) { const size_t hi = ((((size_t)(bb - CB) * DEPTH + l) * 2 + dir) * SG + g) * SP + p; sr = IN_(I_STRE)[hi]; si = IN_(I_STIM)[hi]; }
        for (int c0 = 0; c0 < L; c0 += 16) {
#pragma unroll 4
            for (int s = 0; s < 16; ++s) {
                const int t = dir == 0 ? c0 + s : L - 1 - (c0 + s);
                const v4u* up = (const v4u*)(P + (size_t)(base + t) * NIN + C_U + g * SN);
                const v4u u0 = up[0], u1 = up[1];
                float uu[16]; uu[0] = bflo(u0.x); uu[1] = bfhi(u0.x); uu[2] = bflo(u0.y); uu[3] = bfhi(u0.y); uu[4] = bflo(u0.z); uu[5] = bfhi(u0.z); uu[6] = bflo(u0.w); uu[7] = bfhi(u0.w);
                uu[8] = bflo(u1.x); uu[9] = bfhi(u1.x); uu[10] = bflo(u1.y); uu[11] = bfhi(u1.y); uu[12] = bflo(u1.z); uu[13] = bfhi(u1.z); uu[14] = bflo(u1.w); uu[15] = bfhi(u1.w);
                float br = 0.f, bi = 0.f;
#pragma unroll
                for (int n = 0; n < SN; ++n) { br += bbr[n] * uu[n]; bi += bbi[n] * uu[n]; }
                const float nr_ = ar * sr - ai * si + br, ni_ = ar * si + ai * sr + bi;
                sr = nr_; si = ni_;
                xr[s * 64 + p] = sr; xi[s * 64 + p] = si;
            }
            LDS_WAIT(); asm volatile("" ::: "memory");
            const int s = p >> 2, nq = p & 3;
            const int t = dir == 0 ? c0 + s : L - 1 - (c0 + s);
            float y[4] = {0.f, 0.f, 0.f, 0.f};
            for (int q = 0; q < SP; ++q) { const float a = xr[s * 64 + q], b = xi[s * 64 + q];
#pragma unroll
                for (int j = 0; j < 4; ++j) y[j] += cre[(nq * 4 + j) * 64 + q] * a - cim[(nq * 4 + j) * 64 + q] * b; }
            *(f32x4*)(Ypart + ((size_t)dir * NTOK + base + t) * SSMW + g * SN + nq * 4) = (f32x4){y[0], y[1], y[2], y[3]};
            LDS_WAIT(); asm volatile("" ::: "memory");
        }
        if (ctx) { const size_t oi = ((((size_t)bb * DEPTH + l) * 2 + dir) * SG + g) * SP + p; F.out[O_SR + oi] = sr; F.out[O_SI + oi] = si; }
    }
}
struct OnlineSm { float m, l; float o[HD]; };
__device__ __forceinline__ void ld8(const bf16* p, float* d) { const v4u w = *(const v4u*)p; d[0] = bflo(w.x); d[1] = bfhi(w.x); d[2] = bflo(w.y); d[3] = bfhi(w.y); d[4] = bflo(w.z); d[5] = bfhi(w.z); d[6] = bflo(w.w); d[7] = bfhi(w.w); }
__device__ __forceinline__ void sm_key_bf(OnlineSm& S, const float (&q)[HD], const bf16* k, const bf16* v, float bias) {
    float s = 0.f;
#pragma unroll
    for (int d = 0; d < HD; d += 8) { float kk[8]; ld8(k + d, kk);
#pragma unroll
        for (int e = 0; e < 8; ++e) s += q[d + e] * kk[e]; }
    s += bias;
    const float mn = fmaxf(S.m, s), corr = __builtin_amdgcn_exp2f(S.m - mn), pp = __builtin_amdgcn_exp2f(s - mn);
    S.l = S.l * corr + pp; S.m = mn;
#pragma unroll
    for (int d = 0; d < HD; d += 8) { float vv[8]; ld8(v + d, vv);
#pragma unroll
        for (int e = 0; e < 8; ++e) S.o[d + e] = S.o[d + e] * corr + pp * vv[e]; }
}
__device__ __forceinline__ void sm_key_f32(OnlineSm& S, const float (&q)[HD], const float* k, const float* v) {
    float s = 0.f;
#pragma unroll
    for (int d = 0; d < HD; d += 4) { const f32x4 a = *(const f32x4*)(k + d); s += q[d] * a.x + q[d + 1] * a.y + q[d + 2] * a.z + q[d + 3] * a.w; }
    const float mn = fmaxf(S.m, s), corr = __builtin_amdgcn_exp2f(S.m - mn), pp = __builtin_amdgcn_exp2f(s - mn);
    S.l = S.l * corr + pp; S.m = mn;
#pragma unroll
    for (int d = 0; d < HD; d += 4) { const f32x4 b = *(const f32x4*)(v + d); S.o[d] = S.o[d] * corr + pp * b.x; S.o[d + 1] = S.o[d + 1] * corr + pp * b.y; S.o[d + 2] = S.o[d + 2] * corr + pp * b.z; S.o[d + 3] = S.o[d + 3] * corr + pp * b.w; }
}
__device__ __forceinline__ void phase_attn_naive(const Args& A, Frame& F, const bf16* P, int l, bf16* Ocat) {
    PHASE_IDS();
    const int gt = blockIdx.x * (NWAVES * 64) + tid, ngt = F.G * NWAVES * 64;
    constexpr float L2E = 1.4426950408889634f;
    for (int task = gt; task < 24 * NTOK; task += ngt) {
        const int h24 = task / NTOK; int tok = task % NTOK; tok = tok < NLAT ? NCTX + tok : tok - NLAT;
        const int mixer = h24 / 12, h = h24 % 12;
        const bool ctx = tok < NCTX;
        const bf16* prow = P + (size_t)tok * NIN;
        float q[HD];
        const int qoff = mixer == 0 ? C_QW + h * HD : C_QN + h * HD;
#pragma unroll
        for (int d = 0; d < HD; d += 8) ld8(prow + qoff + d, q + d);
        OnlineSm S; S.m = -3.0e38f; S.l = 0.f;
#pragma unroll
        for (int d = 0; d < HD; ++d) S.o[d] = 0.f;
        const int koff = mixer == 0 ? C_KW + (h / 3) * HD : C_KN + h * HD, voff = mixer == 0 ? C_VW + (h / 3) * HD : C_VN + h * HD;
        if (ctx) {
            const int b = tok / CL;
            for (int j = 0; j < CL; ++j) { const bf16* kr = P + (size_t)(b * CL + j) * NIN; sm_key_bf(S, q, kr + koff, kr + voff, 0.f); }
        } else {
            const int b = (tok - NCTX) / SL, pos = (tok - NCTX) % SL, base = NCTX + b * SL;
            if (mixer == 0) {
                const int lo = pos - 128 < 0 ? 0 : pos - 128, hi = pos + 128 > SL - 1 ? SL - 1 : pos + 128;
                for (int j = lo; j <= hi; ++j) { const bf16* kr = P + (size_t)(base + j) * NIN; sm_key_bf(S, q, kr + koff, kr + voff, 0.f); }
                const int hk = h / 3;
                for (int c = 0; c < PAST; ++c) { const size_t o = ((((size_t)b * DEPTH + l) * PAST + c) * WINKV + hk) * HD; sm_key_f32(S, q, IN_(I_CWK) + o, IN_(I_CWV) + o); }
            } else {
                const int r = pos / 64, cc = pos % 64;
                int rs = r - 4; rs = rs < 0 ? 0 : (rs > 8 ? 8 : rs);
                int cs = cc - 8; cs = cs < 0 ? 0 : (cs > 48 ? 48 : cs);
                const float* rpb = IN_(I_RPB) + ((size_t)l * NAH + h) * 15 * 31;
                for (int kr_ = rs; kr_ < rs + 8; ++kr_)
                    for (int kc = cs; kc < cs + 16; ++kc) { const bf16* kr = P + (size_t)(base + kr_ * 64 + kc) * NIN; const float bias = rpb[(kr_ - r + 7) * 31 + (kc - cc + 15)] * L2E; sm_key_bf(S, q, kr + koff, kr + voff, bias); }
                for (int c = 0; c < PAST; ++c) { const size_t o = ((((size_t)b * DEPTH + l) * PAST + c) * NAH + h) * HD; sm_key_f32(S, q, IN_(I_CNK) + o, IN_(I_CNV) + o); }
            }
        }
        if (mixer == 0) { const float sk = IN_(I_SINK)[l * WINH + h] * L2E; const float mn = fmaxf(S.m, sk), corr = __builtin_amdgcn_exp2f(S.m - mn); S.l = S.l * corr + __builtin_amdgcn_exp2f(sk - mn);
#pragma unroll
            for (int d = 0; d < HD; ++d) S.o[d] *= corr; }
        const float inv = 1.f / S.l;
        bf16* orow = Ocat + (size_t)tok * KBR + (mixer == 0 ? SSMW : 2 * SSMW) + h * HD;
#pragma unroll
        for (int d = 0; d < HD; d += 8) { v4u w; w.x = pk2(S.o[d] * inv, S.o[d + 1] * inv); w.y = pk2(S.o[d + 2] * inv, S.o[d + 3] * inv); w.z = pk2(S.o[d + 4] * inv, S.o[d + 5] * inv); w.w = pk2(S.o[d + 6] * inv, S.o[d + 7] * inv); *(v4u*)(orow + d) = w; }
    }
}

constexpr int PH_PRO = 0, PH_MODR = 1, PH_L0 = 2, PPL = 11, PH_FINAL = PH_L0 + PPL * DEPTH, N_PHASES = PH_FINAL + 1;
__global__ void __launch_bounds__(NWAVES * 64, 2) fwd(Args args) {
    extern __shared__ __attribute__((aligned(16))) unsigned char lds[];
    const Args& A = args;
    Frame F;
    F.lds = (LAS unsigned char*)lds; F.MISC = (volatile LAS unsigned*)(F.lds + MISC_OFF);
    F.G = gridDim.x;
    F.out = args.out; F.ws = args.ws; F.ctl = (gu32*)(args.ws + WS_CTL);
    for (int u = threadIdx.x; u < (LDS_BYTES - LDSCTL_OFF) / 4; u += NWAVES * 64) ((LAS unsigned*)(F.lds + LDSCTL_OFF))[u] = 0u;
    __syncthreads();
    XcdBarrier bar; bar.bar = (unsigned*)(F.ctl + CW_BAR); bar.x = 0; bar.st = nullptr;
    if (!MK_PER_PHASE) bar = xcd_barrier_post((unsigned*)(F.ctl + CW_BAR), F.MISC + 8);
    const int lo = args.ph_lo, hi = args.ph_hi;
#define IN(k) (lo <= (k) && (k) < hi)
#define SEAM(k) do { if (IN(k) && IN((k) + 1)) xcd_barrier(bar); } while (0)
    unsigned char* ws = args.ws;
    float* X = (float*)(ws + WS_X); bf16* H = (bf16*)(ws + WS_H); bf16* PU = (bf16*)(ws + WS_PU); float* Yp = (float*)(ws + WS_YF); bf16* Yg = (bf16*)(ws + WS_YG);
    bf16* Oc = (bf16*)(ws + WS_OC); bf16* Mb = (bf16*)(ws + WS_MB); bf16* act = (bf16*)(ws + WS_ACT);
    const float* mod = (const float*)(ws + WS_MOD);

    if (IN(PH_PRO)) { phase_prologue(args, F); } SEAM(PH_PRO);
    if (IN(PH_MODR)) { phase_mod_reduce(args, F); } SEAM(PH_MODR);
    for (int l = 0; l < DEPTH; ++l) {
        const int pb = PH_L0 + PPL * l;
        const float* mod_l = mod + (size_t)l * 5 * 6 * DM;
        unsigned char* wl = ws + WS_W + (size_t)l * LW_BYTES;
        const float* xa = l == 0 ? IN_(I_XP) : X; const float* xb = l == 0 ? IN_(I_XS) : X + (size_t)NCTX * DM;
        if (IN(pb + 0)) { phase_norm(F, xa, xb, IN_(I_N1G) + (size_t)l * DM, mod_l, 0, 1, H); } SEAM(pb + 0);
        if (IN(pb + 1)) { pg8::Gemm g{H, (const bf16*)(wl + LW_IN), NTOK, NIN, DM}; pg8::StaticOrder S; S.init(NTOK, NIN, F.G, (int)blockIdx.x);
            EpiInProj E{PU, F.out, (const float*)(ws + WS_ROPE), l};
            pg8::gemm_phase<EpiInProj, pg8::StaticOrder, true, true>(F.lds + RING_OFF, g, S, E); } SEAM(pb + 1);
        if (IN(pb + 2)) { phase_ssm(args, F, PU, l, Yp); __syncthreads(); phase_attn_naive(args, F, PU, l, Oc); } SEAM(pb + 2);
        if (IN(pb + 3)) { phase_ssm_post(F, PU, Yp, IN_(I_SSMD) + (size_t)l * SSMW, Yg); } SEAM(pb + 3);
        if (IN(pb + 4)) { pg8::Gemm g{Yg, (const bf16*)(wl + LW_GLU), NTOK, SSMW, SSMW}; pg8::StaticOrder S; S.init(NTOK, SSMW, F.G, (int)blockIdx.x);
            EpiGlu E{Yg, Oc, IN_(I_BGLU) + (size_t)l * SSMW};
            pg8::gemm_phase<EpiGlu, pg8::StaticOrder, true, true>(F.lds + RING_OFF, g, S, E); } SEAM(pb + 4);
        if (IN(pb + 5)) { pg8::Gemm g{Oc, (const bf16*)(wl + LW_BR), NTOK, DM, KBR}; pg8::StaticOrder S; S.init(NTOK, DM, F.G, (int)blockIdx.x);
            EpiBranch E{PU, Mb};
            pg8::gemm_phase<EpiBranch, pg8::StaticOrder, true, true>(F.lds + RING_OFF, g, S, E); } SEAM(pb + 5);
        if (IN(pb + 6)) { pg8::Gemm g{Mb, (const bf16*)(wl + LW_OUT), NTOK, DM, DM}; pg8::StaticOrder S; S.init(NTOK, DM, F.G, (int)blockIdx.x);
            EpiResid E{xa, xb, X, mod_l + 2 * DM};
            pg8::gemm_phase<EpiResid, pg8::StaticOrder, true, true>(F.lds + RING_OFF, g, S, E); } SEAM(pb + 6);
        if (IN(pb + 7)) { phase_norm(F, X, X + (size_t)NCTX * DM, IN_(I_N2G) + (size_t)l * DM, mod_l, 3, 4, H); } SEAM(pb + 7);
        if (IN(pb + 8)) { pg8::Gemm g{H, (const bf16*)(wl + LW_UP), NTOK, NUP, DM}; pg8::StaticOrder S; S.init(NTOK, NUP, F.G, (int)blockIdx.x);
            EpiBf16Plain E{PU, NUP};
            pg8::gemm_phase<EpiBf16Plain, pg8::StaticOrder, true, true>(F.lds + RING_OFF, g, S, E); } SEAM(pb + 8);
        if (IN(pb + 9)) { phase_conv_act(F, PU, IN_(I_CONVW) + (size_t)l * 3 * NUP, IN_(I_CONVB) + (size_t)l * NUP, act); } SEAM(pb + 9);
        if (IN(pb + 10)) { pg8::Gemm g{act, (const bf16*)(wl + LW_DN), NTOK, DM, DFF}; pg8::StaticOrder S; S.init(NTOK, DM, F.G, (int)blockIdx.x);
            EpiResid E{X, X + (size_t)NCTX * DM, X, mod_l + 5 * DM};
            pg8::gemm_phase<EpiResid, pg8::StaticOrder, true, true>(F.lds + RING_OFF, g, S, E); } SEAM(pb + 10);
    }
    if (IN(PH_FINAL)) { phase_final_norm(F, X, IN_(I_FING), F.out); }
#undef IN
#undef SEAM
}

extern "C" void kernel_launch(void* const* d_in, const int* in_sizes, int n_in, void* d_out, int out_size, void* d_ws, size_t ws_size, hipStream_t stream) {
    static int grid = 0;
    if (grid == 0) {
        if (n_in != 34 || (size_t)out_size != O_END || ws_size < WS_END) { fprintf(stderr, "kernel_launch: unexpected problem shape (n_in %d, out %d, ws %zu, need %zu)\n", n_in, out_size, ws_size, (size_t)WS_END); grid = -1; return; }
        int dev = 0, cus = 0, per_cu = 0;
        if (hipGetDevice(&dev) != hipSuccess || hipDeviceGetAttribute(&cus, hipDeviceAttributeMultiprocessorCount, dev) != hipSuccess) { grid = -1; return; }
        if (hipFuncSetAttribute((const void*)fwd, hipFuncAttributeMaxDynamicSharedMemorySize, LDS_BYTES) != hipSuccess) { fprintf(stderr, "kernel_launch: hipFuncSetAttribute failed\n"); grid = -1; return; }
        if (hipOccupancyMaxActiveBlocksPerMultiprocessor(&per_cu, (const void*)fwd, NWAVES * 64, LDS_BYTES) != hipSuccess || per_cu < 1) { fprintf(stderr, "kernel_launch: occupancy query says %d\n", per_cu); }
        (void)hipGetLastError();
        grid = cus;
    }
    if (grid < 0) return;
    if (hipMemsetAsync((char*)d_ws + WS_CTL, 0, CTL_ZERO_BYTES, stream) != hipSuccess) return;
    Args a{};
    for (int i = 0; i < 34; ++i) a.in[i] = (const float*)d_in[i];
    a.out = (float*)d_out; a.ws = (unsigned char*)d_ws;
#if MK_PER_PHASE
    for (int p = 0; p < N_PHASES; ++p) { a.ph_lo = p; a.ph_hi = p + 1; hipLaunchKernelGGL(fwd, dim3(grid), dim3(NWAVES * 64), LDS_BYTES, stream, a); }
#else
    a.ph_lo = 0; a.ph_hi = N_PHASES; hipLaunchKernelGGL(fwd, dim3(grid), dim3(NWAVES * 64), LDS_BYTES, stream, a);
#endif
}
```

```cpp
#include <hip/hip_runtime.h>
#include <cstdio>
#include <cstdint>

#define MK_PER_PHASE 0

namespace pg8 {
#define PG8_LAS __attribute__((address_space(3)))
typedef unsigned short bf16_t;
typedef short bf16x8 __attribute__((ext_vector_type(8)));
typedef float f32x4 __attribute__((ext_vector_type(4)));
typedef unsigned u32x4 __attribute__((ext_vector_type(4)));
constexpr int BM = 256, BK = 64, HALF = 128, HTB = HALF * BK * 2  , STAGE_BYTES = 8 * HTB, NXCD = 8, WGM = 8;

__host__ __device__ __forceinline__ int lds_byte(int r, int c) { const int st = (r >> 4) * 2 + (c >> 5), rr = r & 15, cc = c & 31, ob = rr * 64 + cc * 2; return st * 1024 + (ob ^ (((ob >> 9) & 1) << 5)); }
__host__ __device__ __forceinline__ void stage_rc(int b, int& R, int& C) { const int st = b / 1024, sb = b % 1024, swz = sb ^ (((sb >> 9) & 1) << 5); R = (st >> 1) * 16 + swz / 64; C = (st & 1) * 32 + (swz % 64) / 2; }
__host__ __device__ __forceinline__ int perm32(int rho) { const int n = rho >> 4, i = rho & 15; return 8 * (i >> 2) + 4 * n + (i & 3); }

struct Unit { int pm, pn; };
struct Gemm { const bf16_t* A; const bf16_t* Bt; int M, N, K; };

struct StaticOrder {
    int nM, nN, nwg, G, c;
    __host__ __device__ void init(int M, int N, int G_, int c_) { nM = M / BM; nN = N / BM; nwg = nM * nN; G = G_; c = c_; }
    __host__ __device__ bool next(int i, Unit& u) const {
        const long L = (long)i * G + c; if (L >= nwg) return false;
        int wgid = (int)L; { const int q = nwg / NXCD, r = nwg % NXCD, xcd = wgid % NXCD, off = wgid / NXCD; wgid = (xcd < r ? xcd * (q + 1) : r * (q + 1) + (xcd - r) * q) + off; }
        const int nig = WGM * nN, gid = wgid / nig, fm = gid * WGM, gsz = (nM - fm) < WGM ? (nM - fm) : WGM;
        u.pm = fm + ((wgid % nig) % gsz); u.pn = (wgid % nig) / gsz; return true;
    }
    __device__ __forceinline__ void a_ready(const Unit&) const {}
    __device__ __forceinline__ void done(const Unit&) const {}
};
__device__ __forceinline__ unsigned cvt_pk_bf16(float lo, float hi) { unsigned r; asm volatile("v_cvt_pk_bf16_f32 %0, %1, %2" : "=v"(r) : "v"(lo), "v"(hi)); return r; }
typedef float f32x2 __attribute__((ext_vector_type(2)));
template <class Epi, class Sched, bool ALIGN_EPI = false, bool SP2 = false>
__device__ __forceinline__ void gemm_phase(PG8_LAS unsigned char* lds, const Gemm g, const Sched& S, const Epi& E) {
    int tid_ = threadIdx.x; asm volatile("" : "+v"(tid_));
    const int tid = tid_, wid = __builtin_amdgcn_readfirstlane(tid >> 6), lane = tid & 63, wr = wid >> 2, wc = wid & 3, fr = lane & 15, fq = lane >> 4;
    const int K = g.K, nt = K / BK;
    unsigned voffA[2], voffB[2];
#pragma unroll
    for (int i = 0; i < 2; ++i) { int R, C; stage_rc(tid * 16 + i * 8192, R, C); const int Rb = Epi::PERM ? ((R & ~31) + perm32(R & 31)) : R;
        voffA[i] = (unsigned)(R * K + C) * 2u; voffB[i] = (unsigned)(Rb * K + C) * 2u; }
    const size_t kstep = (size_t)(BK * 2);
    const size_t hstep = (size_t)HALF * K * 2;
    const size_t tstep = 2 * hstep;
    const unsigned ldsw = (unsigned)wid * 1024u;
    const int aoff = lds_byte(wr * 64 + fr, fq * 8), boff = lds_byte(wc * 32 + fr, fq * 8);
#define PG8_SA(b, h) (((b) * 2 + (h)) * HTB)
#define PG8_SB(b, h) ((4 + (b) * 2 + (h)) * HTB)
#define PG8_STAGE(bufoff, gbase, voff) do { _Pragma("unroll") for (int _i = 0; _i < 2; ++_i) \
        __builtin_amdgcn_global_load_lds((const unsigned*)((const char*)(gbase) + (voff)[_i]), (PG8_LAS unsigned*)(lds + (bufoff) + ldsw + _i * 8192), 16, 0, 0); } while (0)
#define PG8_LDA(dst, b, h) do { _Pragma("unroll") for (int m = 0; m < 4; ++m) _Pragma("unroll") for (int k = 0; k < 2; ++k) dst[m][k] = *(const PG8_LAS bf16x8*)(lds + PG8_SA(b, h) + aoff + m * 2048 + k * 1024); } while (0)
#define PG8_LDB(dst, b, h) do { _Pragma("unroll") for (int n = 0; n < 2; ++n) _Pragma("unroll") for (int k = 0; k < 2; ++k) dst[n][k] = *(const PG8_LAS bf16x8*)(lds + PG8_SB(b, h) + boff + n * 2048 + k * 1024); } while (0)
#define PG8_MMA(ai, bj, At, Bt) do { __builtin_amdgcn_s_setprio(1); _Pragma("unroll") for (int m = 0; m < 4; ++m) _Pragma("unroll") for (int n = 0; n < 2; ++n) _Pragma("unroll") for (int k = 0; k < 2; ++k) \
        acc[ai][bj][m][n] = __builtin_amdgcn_mfma_f32_16x16x32_bf16(Bt[n][k], At[m][k], acc[ai][bj][m][n], 0, 0, 0); __builtin_amdgcn_s_setprio(0); } while (0)
#define PG8_WAIT_V(n) asm volatile("s_waitcnt vmcnt(" #n ")" ::: "memory")
#define PG8_WAIT_L(n) asm volatile("s_waitcnt lgkmcnt(" #n ")" ::: "memory")
#define PG8_BAR __builtin_amdgcn_s_barrier()
#define PG8_SCHED __builtin_amdgcn_sched_barrier(0)
    Unit cur, nxt; int ui = 0;
    if (!S.next(0, cur)) return;
    f32x4 acc[2][2][4][2];
#pragma unroll
    for (int a = 0; a < 2; ++a)
#pragma unroll
        for (int b = 0; b < 2; ++b)
#pragma unroll
            for (int m = 0; m < 4; ++m)
#pragma unroll
                for (int n = 0; n < 2; ++n) acc[a][b][m][n] = (f32x4){0.f, 0.f, 0.f, 0.f};
    bf16x8 At[4][2], B0[2][2], B1[2][2];
    const char* cA = (const char*)g.A + (size_t)cur.pm * tstep; const char* cB = (const char*)g.Bt + (size_t)cur.pn * tstep;
    S.a_ready(cur);
    if constexpr (SP2) {
        PG8_STAGE(PG8_SB(0, 0), cB, voffB); PG8_STAGE(PG8_SB(0, 1), cB + hstep, voffB); PG8_STAGE(PG8_SA(0, 0), cA, voffA); PG8_STAGE(PG8_SA(0, 1), cA + hstep, voffA);
        if (wr == 1) PG8_BAR;
        PG8_WAIT_V(2); PG8_BAR;
        PG8_STAGE(PG8_SB(1, 0), cB + kstep, voffB); PG8_STAGE(PG8_SA(1, 0), cA + kstep, voffA); PG8_STAGE(PG8_SB(1, 1), cB + hstep + kstep, voffB);
        PG8_WAIT_V(6); PG8_BAR;
    } else {
        PG8_STAGE(PG8_SB(0, 0), cB, voffB); PG8_STAGE(PG8_SA(0, 0), cA, voffA); PG8_STAGE(PG8_SB(0, 1), cB + hstep, voffB); PG8_STAGE(PG8_SA(0, 1), cA + hstep, voffA);
        if (wr == 1) PG8_BAR;
        PG8_WAIT_V(4); PG8_BAR;
        PG8_STAGE(PG8_SB(1, 0), cB + kstep, voffB); PG8_STAGE(PG8_SA(1, 0), cA + kstep, voffA); PG8_STAGE(PG8_SB(1, 1), cB + hstep + kstep, voffB);
        PG8_WAIT_V(6); PG8_BAR;
    }
    for (;;) {
        const bool has_next = S.next(ui + 1, nxt);
        const char* nA = has_next ? (const char*)g.A + (size_t)nxt.pm * tstep : cA; const char* nB = has_next ? (const char*)g.Bt + (size_t)nxt.pn * tstep : cB;
        for (int t = 0; t < nt; t += 2) {
            const bool last = (t == nt - 2);
            const char* a1 = cA + (size_t)(t + 1) * kstep;
            const char* a2 = last ? nA : cA + (size_t)(t + 2) * kstep; const char* b2 = last ? nB : cB + (size_t)(t + 2) * kstep;
            const char* a3 = a2 + kstep; const char* b3 = b2 + kstep;
            if (last && has_next) S.a_ready(nxt);
            if constexpr (SP2) {
            PG8_LDB(B0, 0, 0); PG8_LDB(B1, 0, 1); PG8_SCHED; PG8_LDA(At, 0, 0); PG8_STAGE(PG8_SA(1, 1), a1 + hstep, voffA);
            PG8_WAIT_V(8); PG8_WAIT_L(0); PG8_BAR; PG8_MMA(0, 0, At, B0); PG8_MMA(0, 1, At, B1); PG8_BAR; PG8_SCHED;
            PG8_LDA(At, 0, 1); PG8_STAGE(PG8_SB(0, 0), b2, voffB); PG8_STAGE(PG8_SB(0, 1), b2 + hstep, voffB); PG8_STAGE(PG8_SA(0, 0), a2, voffA);
            PG8_WAIT_V(8); PG8_WAIT_L(0); PG8_BAR; PG8_MMA(1, 0, At, B0); PG8_MMA(1, 1, At, B1); PG8_BAR; PG8_SCHED;
            PG8_LDB(B0, 1, 0); PG8_LDB(B1, 1, 1); PG8_SCHED; PG8_LDA(At, 1, 0); PG8_STAGE(PG8_SA(0, 1), a2 + hstep, voffA);
            PG8_WAIT_V(8); PG8_WAIT_L(0); PG8_BAR; PG8_MMA(0, 0, At, B0); PG8_MMA(0, 1, At, B1); PG8_BAR; PG8_SCHED;
            PG8_LDA(At, 1, 1); PG8_STAGE(PG8_SB(1, 0), b3, voffB); PG8_STAGE(PG8_SB(1, 1), b3 + hstep, voffB); PG8_STAGE(PG8_SA(1, 0), a3, voffA);
            PG8_WAIT_V(8); PG8_WAIT_L(0); PG8_BAR; PG8_MMA(1, 0, At, B0); PG8_MMA(1, 1, At, B1); PG8_BAR; PG8_SCHED;
            } else {
            PG8_LDB(B0, 0, 0); PG8_SCHED; PG8_LDA(At, 0, 0); PG8_STAGE(PG8_SA(1, 1), a1 + hstep, voffA);
            PG8_WAIT_L(8); PG8_BAR; PG8_WAIT_L(0); PG8_MMA(0, 0, At, B0); PG8_BAR; PG8_SCHED;
            PG8_LDB(B1, 0, 1); PG8_STAGE(PG8_SB(0, 0), b2, voffB);
            PG8_BAR; PG8_WAIT_L(0); PG8_MMA(0, 1, At, B1); PG8_BAR;
            PG8_LDA(At, 0, 1); PG8_STAGE(PG8_SA(0, 0), a2, voffA);
            PG8_BAR; PG8_WAIT_L(0); PG8_MMA(1, 0, At, B0); PG8_BAR; PG8_SCHED;
            PG8_STAGE(PG8_SB(0, 1), b2 + hstep, voffB);
            PG8_WAIT_V(6); PG8_BAR; PG8_MMA(1, 1, At, B1); PG8_BAR;
            PG8_LDB(B0, 1, 0); PG8_SCHED; PG8_LDA(At, 1, 0); PG8_STAGE(PG8_SA(0, 1), a2 + hstep, voffA);
            PG8_WAIT_L(8); PG8_BAR; PG8_WAIT_L(0); PG8_MMA(0, 0, At, B0); PG8_BAR; PG8_SCHED;
            PG8_LDB(B1, 1, 1); PG8_STAGE(PG8_SB(1, 0), b3, voffB);
            PG8_BAR; PG8_WAIT_L(0); PG8_MMA(0, 1, At, B1); PG8_BAR;
            PG8_LDA(At, 1, 1); PG8_STAGE(PG8_SA(1, 0), a3, voffA);
            PG8_BAR; PG8_WAIT_L(0); PG8_MMA(1, 0, At, B0); PG8_BAR; PG8_SCHED;
            PG8_STAGE(PG8_SB(1, 1), b3 + hstep, voffB);
            PG8_WAIT_V(6); PG8_BAR; PG8_MMA(1, 1, At, B1); PG8_BAR;
            }
            if constexpr (Epi::HAS_MID) { E.mid(acc, cur, t + 2, wr, wc, fr, fq); }
        }
        if constexpr (ALIGN_EPI) { if (wr == 0) PG8_BAR; }
        if constexpr (!Epi::AFTER_DRAIN) { E(acc, cur, wr, wc, fr, fq); S.done(cur); }
        if (!has_next) break;
#pragma unroll
        for (int a = 0; a < 2; ++a)
#pragma unroll
            for (int b = 0; b < 2; ++b)
#pragma unroll
                for (int m = 0; m < 4; ++m)
#pragma unroll
                    for (int n = 0; n < 2; ++n) acc[a][b][m][n] = (f32x4){0.f, 0.f, 0.f, 0.f};
        cur = nxt; cA = nA; cB = nB; ++ui;
        if constexpr (ALIGN_EPI) { if (wr == 1) PG8_BAR; }
    }
    PG8_WAIT_V(0);
    if constexpr (!ALIGN_EPI) { if (wr == 0) PG8_BAR; }
    PG8_BAR;
    if constexpr (Epi::AFTER_DRAIN) { E.fused(acc, cur, wr, wc, fr, fq, lds, wid, lane); S.done(cur); }
#undef PG8_SA
#undef PG8_SB
#undef PG8_STAGE
#undef PG8_LDA
#undef PG8_LDB
#undef PG8_MMA
#undef PG8_WAIT_V
#undef PG8_WAIT_L
#undef PG8_BAR
#undef PG8_SCHED
}
}

constexpr int DM = 2048, DEPTH = 4;
constexpr int CB = 16, CL = 256, SB = 4, SL = 1024, PAST = 512;
constexpr int NCTX = CB * CL, NLAT = SB * SL, NTOK = NCTX + NLAT;
constexpr int HD = 64, SSMW = 768, SG = 48, SP = 64, SN = 16;
constexpr int WINH = 12, WINKV = 4, NAH = 12;
constexpr int DFF = 5632, NUP = 2 * DFF, NIN = 10496, KBR = 3 * SSMW;
constexpr int C_U = 0, C_QW = 768, C_KW = 1536, C_VW = 1792, C_QN = 2048, C_KN = 2816, C_VN = 3584, C_GA = 4352, C_GB = 6400, C_GC = 8448;
constexpr float QSCALE = 0.125f * 1.4426950408889634f;
constexpr size_t O_YP = 0, O_YS = O_YP + (size_t)NCTX * DM, O_WK = O_YS + (size_t)NLAT * DM;
constexpr size_t SZ_WKV = (size_t)CB * DEPTH * CL * WINKV * HD, SZ_NKV = (size_t)CB * DEPTH * CL * NAH * HD, SZ_SS = (size_t)CB * DEPTH * 2 * SG * SP;
constexpr size_t O_WV = O_WK + SZ_WKV, O_NK = O_WV + SZ_WKV, O_NV = O_NK + SZ_NKV, O_SR = O_NV + SZ_NKV, O_SI = O_SR + SZ_SS, O_END = O_SI + SZ_SS;

constexpr size_t MiB = 1u << 20;
constexpr size_t WS_CTL = 0, CTL_ZERO_BYTES = 1 * MiB;
constexpr size_t WS_MOD = 1 * MiB;
constexpr size_t WS_MODP = 2 * MiB;
constexpr size_t WS_SSMT = 18 * MiB;
constexpr size_t SSMT_LAM = 0, SSMT_BB = 256 * 1024;
constexpr size_t WS_ROPE = 23 * MiB;
constexpr size_t WS_W = 24 * MiB;
constexpr size_t LW_IN = 0, LW_GLU = LW_IN + (size_t)NIN * DM * 2, LW_BR = LW_GLU + (size_t)SSMW * SSMW * 2, LW_OUT = LW_BR + (size_t)DM * KBR * 2,
                 LW_UP = LW_OUT + (size_t)DM * DM * 2, LW_DN = LW_UP + (size_t)NUP * DM * 2, LW_BYTES = LW_DN + (size_t)DM * DFF * 2;
constexpr size_t WS_X = WS_W + 4 * LW_BYTES + MiB - (4 * LW_BYTES) % MiB;
constexpr size_t WS_H = WS_X + (size_t)NTOK * DM * 4;
constexpr size_t WS_PU = WS_H + (size_t)NTOK * DM * 2;
constexpr size_t WS_YF = WS_PU + (size_t)NTOK * NUP * 2;
constexpr size_t WS_YG = WS_YF + (size_t)2 * NTOK * SSMW * 4;
constexpr size_t WS_OC = WS_YG + (size_t)NTOK * SSMW * 2;
constexpr size_t WS_MB = WS_OC + (size_t)NTOK * KBR * 2;
constexpr size_t WS_ACT = WS_MB + (size_t)NTOK * DM * 2;
constexpr size_t WS_CWK = WS_ACT + (size_t)NTOK * DFF * 2;
constexpr size_t SZ_CW = (size_t)SB * DEPTH * PAST * WINKV * HD, SZ_CN = (size_t)SB * DEPTH * PAST * NAH * HD;
constexpr size_t WS_CWV = WS_CWK + SZ_CW * 2, WS_CNK = WS_CWV + SZ_CW * 2, WS_CNV = WS_CNK + SZ_CN * 2;
constexpr size_t WS_END = WS_CNV + SZ_CN * 2;
constexpr int CW_TMO = 0, CW_BAR = 4096;

constexpr int NWAVES = 8;
constexpr int RING_OFF = 0, RING_BYTES = 131072, LDSCTL_OFF = RING_BYTES, MISC_OFF = LDSCTL_OFF + 320, LDS_BYTES = 147456;

#define GAS __attribute__((address_space(1)))
#define LAS __attribute__((address_space(3)))
typedef unsigned short bf16;
typedef unsigned v4u __attribute__((ext_vector_type(4)));
typedef unsigned v2u __attribute__((ext_vector_type(2)));
typedef float f32x4 __attribute__((ext_vector_type(4)));
typedef GAS unsigned gu32;
#define RLX_AGENT __ATOMIC_RELAXED, __HIP_MEMORY_SCOPE_AGENT
#define LDS_WAIT() asm volatile("s_waitcnt lgkmcnt(0)" ::: "memory")
#define VM_WAIT() asm volatile("s_waitcnt vmcnt(0)" ::: "memory")
__device__ __forceinline__ unsigned f2bf(float f) { unsigned u = __builtin_bit_cast(unsigned, f); return (u + 0x7fffu + ((u >> 16) & 1u)) >> 16; }
__device__ __forceinline__ unsigned pk2(float lo, float hi) { return f2bf(lo) | (f2bf(hi) << 16); }
__device__ __forceinline__ float bflo(unsigned u) { return __uint_as_float(u << 16); }
__device__ __forceinline__ float bfhi(unsigned u) { return __uint_as_float(u & 0xffff0000u); }
__device__ __forceinline__ float bf2f(bf16 h) { return __uint_as_float((unsigned)h << 16); }
__device__ __forceinline__ float fexp(float x) { return __builtin_amdgcn_exp2f(x * 1.4426950408889634f); }
__device__ __forceinline__ float frcp(float x) { return __builtin_amdgcn_rcpf(x); }
__device__ __forceinline__ float sigm(float x) { return frcp(1.f + fexp(fminf(-x, 80.f))); }
__device__ __forceinline__ float gelu_tanh(float x) { const float u = 0.7978845608028654f * (x + 0.044715f * x * x * x); return x * frcp(1.f + fexp(fminf(-2.f * u, 80.f))); }
__device__ __forceinline__ int cond_of(int tok) { return tok < NCTX ? 0 : 1 + ((tok - NCTX) >> 10); }

#define XB_TMO      128
#define XB_XCNT(j)  (256  + 64 * (j))
#define XB_XSUB(j)  (1280 + 64 * (j))
#define XB_XGEN(j)  (2304 + 64 * (j))
#define XB_TOP      3328
#define XB_TOPGEN   3392
#define XCD_BAR_WORDS 3456
#define XB_SPIN_CAP (1u << 18)

__device__ __forceinline__ unsigned xb_ld(unsigned* p)              { return __hip_atomic_load(p, __ATOMIC_RELAXED, __HIP_MEMORY_SCOPE_AGENT); }
__device__ __forceinline__ unsigned xb_add(unsigned* p, unsigned v) { return __hip_atomic_fetch_add(p, v, __ATOMIC_RELAXED, __HIP_MEMORY_SCOPE_AGENT); }
__device__ __forceinline__ unsigned xb_xcc_id() { return (unsigned)__builtin_amdgcn_s_getreg((3 << 11) | 20) & 0xFu; }
#define XB_SPIN(cond, bar) do { unsigned _sp = 0; while (cond) { __builtin_amdgcn_s_sleep(1); \
    if ((++_sp & 255u) == 0u) { if (xb_ld(&(bar)[XB_TMO])) break; if (_sp > XB_SPIN_CAP) { atomicAdd(&(bar)[XB_TMO], 1u); break; } } } } while (0)

struct XcdBarrier {
    unsigned* bar; unsigned x;
    volatile LAS unsigned* st;
};

__device__ __forceinline__ XcdBarrier xcd_barrier_post(unsigned* bar, volatile LAS unsigned* st) {
    XcdBarrier b; b.bar = bar; b.x = xb_xcc_id(); b.st = st;
    if (threadIdx.x == 0) (void)xb_add(&bar[XB_XCNT(b.x)], 1u);
    return b;
}
__device__ __forceinline__ void xcd_barrier_complete(unsigned* bar, unsigned x, unsigned& nloc, unsigned& nx) {
    const unsigned G = gridDim.x * gridDim.y * gridDim.z;
    unsigned sum, cnt, mine, sp = 0u;
    for (;;) {
        sum = 0u; cnt = 0u; mine = 0u;
#pragma unroll
        for (unsigned j = 0; j < 16; ++j) { const unsigned c = xb_ld(&bar[XB_XCNT(j)]); sum += c; cnt += (c > 0u) ? 1u : 0u; mine = (j == x) ? c : mine; }
        if (sum == G) break;
        __builtin_amdgcn_s_sleep(1);
        if ((++sp & 255u) == 0u) { if (xb_ld(&bar[XB_TMO])) break; if (sp > XB_SPIN_CAP) { atomicAdd(&bar[XB_TMO], 1u); break; } }
    }
    nloc = mine > 0u ? mine : 1u; nx = cnt > 0u ? cnt : 1u;
}

__device__ __forceinline__ void xcd_barrier(const XcdBarrier& b) {
    asm volatile("s_waitcnt vmcnt(0)" ::: "memory");
    __syncthreads();
    if (threadIdx.x == 0) {
        unsigned* bar = b.bar;
        __builtin_amdgcn_s_waitcnt(0);
        unsigned nloc = b.st[0], nx = b.st[1];
        if (nloc == 0u) { xcd_barrier_complete(bar, b.x, nloc, nx); b.st[0] = nloc; b.st[1] = nx; }
        const unsigned old = xb_add(&bar[XB_XSUB(b.x)], 1u);
        const unsigned gen = old / nloc;
        if (old + 1u == (gen + 1u) * nloc) {
            __builtin_amdgcn_fence(__ATOMIC_RELEASE, "agent");
            asm volatile("s_waitcnt vmcnt(0)" ::: "memory");
            const unsigned og = xb_add(&bar[XB_TOP], 1u);
            const unsigned tg = og / nx;
            if (og + 1u == (tg + 1u) * nx) xb_add(&bar[XB_TOPGEN], 1u);
            else XB_SPIN(xb_ld(&bar[XB_TOPGEN]) == tg, bar);
            __builtin_amdgcn_fence(__ATOMIC_ACQUIRE, "agent");
            xb_add(&bar[XB_XGEN(b.x)], 1u);
            asm volatile("s_waitcnt vmcnt(0)" ::: "memory");
        } else {
            XB_SPIN(xb_ld(&bar[XB_XGEN(b.x)]) == gen, bar);
            __builtin_amdgcn_fence(__ATOMIC_ACQUIRE, "agent");
            asm volatile("s_waitcnt vmcnt(0)" ::: "memory");
        }
    }
    __syncthreads();
}

struct Args { const float* in[34]; float* out; unsigned char* ws; int ph_lo, ph_hi; };
struct Frame {
    LAS unsigned char* lds; volatile LAS unsigned* MISC; gu32* ctl;
    int G;
    float* out; unsigned char* ws;
};
#define IN_(k) (A.in[k])
enum { I_XP = 0, I_XS, I_CWK, I_CWV, I_CNK, I_CNV, I_STRE, I_STIM, I_C, I_CCTX, I_N1G, I_N2G, I_WMOD, I_BMOD, I_WIN, I_LAMRE, I_LAMIM, I_LOGDT, I_BRE, I_BIM, I_CRE, I_CIM,
       I_SSMD, I_WGLU, I_BGLU, I_SINK, I_RPB, I_WBR, I_WOUT, I_WUP, I_CONVW, I_CONVB, I_WDN, I_FING };

#define PHASE_IDS() int tid = threadIdx.x; asm volatile("" : "+v"(tid)); const int lane = tid & 63, wave = __builtin_amdgcn_readfirstlane(tid >> 6), gw = blockIdx.x * NWAVES + wave, ngw = F.G * NWAVES; (void)lane; (void)gw; (void)ngw
__device__ __forceinline__ float wave_sum(float v) {
#pragma unroll
    for (int o = 1; o < 64; o <<= 1) v += __shfl_xor(v, o);
    return v;
}

using pg8::Unit;
struct EpiInProj {
    static constexpr bool PERM = true, AFTER_DRAIN = false, HAS_MID = false;
    bf16* P; float* out; const float* rope; int layer;
    __device__ __forceinline__ void mid(f32x4 (&)[2][2][4][2], const Unit&, int, int, int, int, int) const {}
    __device__ __forceinline__ void operator()(const f32x4 (&acc)[2][2][4][2], const Unit& u, int wr, int wc, int fr, int fq) const {
        const int row0 = u.pm * 256 + wr * 64 + fr, colt = wc * 32 + 8 * fq, pn = u.pn;
        const bool lat = u.pm >= CB;
        const bool do_rope = lat && pn >= 3 && pn <= 6;
        const float qs = ((pn >= 3 && pn <= 5) || (pn >= 8 && pn <= 10)) ? QSCALE : 1.f;
        float* obase = nullptr; int ow = 0, ocol = 0;
        if (!lat) { if (pn == 6) { obase = out + O_WK; ow = 256; } else if (pn == 7) { obase = out + O_WV; ow = 256; }
                    else if (pn >= 11 && pn <= 13) { obase = out + O_NK; ow = 768; ocol = (pn - 11) * 256; } else if (pn >= 14 && pn <= 16) { obase = out + O_NV; ow = 768; ocol = (pn - 14) * 256; } }
        const float sgn = fq < 2 ? -1.f : 1.f; const int i0 = 8 * (fq & 1);
#pragma unroll
        for (int ai = 0; ai < 2; ++ai)
#pragma unroll
            for (int m = 0; m < 4; ++m) { const int row = row0 + ai * 128 + m * 16;
                f32x4 cs0 = {1.f, 1.f, 1.f, 1.f}, cs1 = cs0, sn0 = {0.f, 0.f, 0.f, 0.f}, sn1 = sn0;
                if (do_rope) { const int pos = (row - NCTX) & (SL - 1); const int comp = (wc & 1) ? (pos & 63) : (pos >> 6); const float* rt = rope + comp * 32 + i0;
                    cs0 = *(const f32x4*)(rt); cs1 = *(const f32x4*)(rt + 4); sn0 = *(const f32x4*)(rt + 16); sn1 = *(const f32x4*)(rt + 20); }
                bf16* prow = P + (size_t)row * NIN + pn * 256 + colt;
#pragma unroll
                for (int bj = 0; bj < 2; ++bj) { f32x4 v0 = acc[ai][bj][m][0], v1 = acc[ai][bj][m][1];
                    if (obase) { float* o = obase + ((size_t)(u.pm * DEPTH + layer) * CL + (row & 255)) * ow + ocol + colt + bj * 128; *(f32x4*)o = v0; *(f32x4*)(o + 4) = v1; }
                    if (do_rope) { f32x4 p0, p1;
#pragma unroll
                        for (int e = 0; e < 4; ++e) { p0[e] = __shfl_xor(v0[e], 32); p1[e] = __shfl_xor(v1[e], 32); }
                        v0 = v0 * cs0 + (p0 * sgn) * sn0; v1 = v1 * cs1 + (p1 * sgn) * sn1; }
                    v0 = v0 * qs; v1 = v1 * qs;
                    v4u w; w.x = pg8::cvt_pk_bf16(v0[0], v0[1]); w.y = pg8::cvt_pk_bf16(v0[2], v0[3]); w.z = pg8::cvt_pk_bf16(v1[0], v1[1]); w.w = pg8::cvt_pk_bf16(v1[2], v1[3]);
                    *(v4u*)(prow + bj * 128) = w; } }
    }
};
struct EpiBf16Plain {
    static constexpr bool PERM = true, AFTER_DRAIN = false, HAS_MID = false;
    bf16* O; int ldc;
    __device__ __forceinline__ void mid(f32x4 (&)[2][2][4][2], const Unit&, int, int, int, int, int) const {}
    __device__ __forceinline__ void operator()(const f32x4 (&acc)[2][2][4][2], const Unit& u, int wr, int wc, int fr, int fq) const {
        const int row0 = u.pm * 256 + wr * 64 + fr, col0 = u.pn * 256 + wc * 32 + 8 * fq;
#pragma unroll
        for (int ai = 0; ai < 2; ++ai)
#pragma unroll
            for (int m = 0; m < 4; ++m) { bf16* rowp = O + (size_t)(row0 + ai * 128 + m * 16) * ldc + col0;
#pragma unroll
                for (int bj = 0; bj < 2; ++bj) { const f32x4 v0 = acc[ai][bj][m][0], v1 = acc[ai][bj][m][1];
                    v4u w; w.x = pg8::cvt_pk_bf16(v0[0], v0[1]); w.y = pg8::cvt_pk_bf16(v0[2], v0[3]); w.z = pg8::cvt_pk_bf16(v1[0], v1[1]); w.w = pg8::cvt_pk_bf16(v1[2], v1[3]);
                    *(v4u*)(rowp + bj * 128) = w; } }
    }
};
struct EpiGlu {
    static constexpr bool PERM = true, AFTER_DRAIN = false, HAS_MID = false;
    const bf16* Y; bf16* O; const float* bias;
    __device__ __forceinline__ void mid(f32x4 (&)[2][2][4][2], const Unit&, int, int, int, int, int) const {}
    __device__ __forceinline__ void operator()(const f32x4 (&acc)[2][2][4][2], const Unit& u, int wr, int wc, int fr, int fq) const {
        const int row0 = u.pm * 256 + wr * 64 + fr, col0 = u.pn * 256 + wc * 32 + 8 * fq;
        f32x4 bv[2][2];
#pragma unroll
        for (int bj = 0; bj < 2; ++bj) { bv[bj][0] = *(const f32x4*)(bias + col0 + bj * 128); bv[bj][1] = *(const f32x4*)(bias + col0 + bj * 128 + 4); }
#pragma unroll
        for (int ai = 0; ai < 2; ++ai)
#pragma unroll
            for (int m = 0; m < 4; ++m) { const size_t row = row0 + ai * 128 + m * 16;
#pragma unroll
                for (int bj = 0; bj < 2; ++bj) { const v4u y = *(const v4u*)(Y + row * SSMW + col0 + bj * 128);
                    const f32x4 v0 = acc[ai][bj][m][0] + bv[bj][0], v1 = acc[ai][bj][m][1] + bv[bj][1];
                    v4u w; w.x = pg8::cvt_pk_bf16(bflo(y.x) * sigm(v0[0]), bfhi(y.x) * sigm(v0[1])); w.y = pg8::cvt_pk_bf16(bflo(y.y) * sigm(v0[2]), bfhi(y.y) * sigm(v0[3]));
                    w.z = pg8::cvt_pk_bf16(bflo(y.z) * sigm(v1[0]), bfhi(y.z) * sigm(v1[1])); w.w = pg8::cvt_pk_bf16(bflo(y.w) * sigm(v1[2]), bfhi(y.w) * sigm(v1[3]));
                    *(v4u*)(O + row * KBR + col0 + bj * 128) = w; } }
    }
};
struct EpiBranch {
    static constexpr bool PERM = true, AFTER_DRAIN = false, HAS_MID = true;
    const bf16* P; bf16* M;
    __device__ __forceinline__ void mid(f32x4 (&acc)[2][2][4][2], const Unit& u, int tnext, int wr, int wc, int fr, int fq) const {
        if (tnext != 12 && tnext != 24) return;
        asm volatile("" : "+v"(fr), "+v"(fq));
        const int cnum = tnext == 12 ? C_GA : C_GB, cden = tnext == 12 ? C_GB : C_GC;
        const int row0 = u.pm * 256 + wr * 64 + fr, col0 = u.pn * 256 + wc * 32 + 8 * fq;
#pragma unroll
        for (int ai = 0; ai < 2; ++ai)
#pragma unroll
            for (int m = 0; m < 4; ++m) { const bf16* prow = P + (size_t)(row0 + ai * 128 + m * 16) * NIN + col0;
#pragma unroll
                for (int bj = 0; bj < 2; ++bj) { const v4u a = *(const v4u*)(prow + cnum + bj * 128), b = *(const v4u*)(prow + cden + bj * 128);
#define RAT(x, y) ((1.f + fexp(fminf(-(y), 80.f))) * frcp(1.f + fexp(fminf(-(x), 80.f))))
                    f32x4 r0, r1; r0[0] = RAT(bflo(a.x), bflo(b.x)); r0[1] = RAT(bfhi(a.x), bfhi(b.x)); r0[2] = RAT(bflo(a.y), bflo(b.y)); r0[3] = RAT(bfhi(a.y), bfhi(b.y));
                    r1[0] = RAT(bflo(a.z), bflo(b.z)); r1[1] = RAT(bfhi(a.z), bfhi(b.z)); r1[2] = RAT(bflo(a.w), bflo(b.w)); r1[3] = RAT(bfhi(a.w), bfhi(b.w));
#undef RAT
                    acc[ai][bj][m][0] = acc[ai][bj][m][0] * r0; acc[ai][bj][m][1] = acc[ai][bj][m][1] * r1; } }
    }
    __device__ __forceinline__ void operator()(const f32x4 (&acc)[2][2][4][2], const Unit& u, int wr, int wc, int fr, int fq) const {
        const int row0 = u.pm * 256 + wr * 64 + fr, col0 = u.pn * 256 + wc * 32 + 8 * fq;
#pragma unroll
        for (int ai = 0; ai < 2; ++ai)
#pragma unroll
            for (int m = 0; m < 4; ++m) { const size_t row = row0 + ai * 128 + m * 16;
#pragma unroll
                for (int bj = 0; bj < 2; ++bj) { const v4u g = *(const v4u*)(P + row * NIN + C_GC + col0 + bj * 128);
                    const f32x4 v0 = acc[ai][bj][m][0], v1 = acc[ai][bj][m][1];
                    v4u w; w.x = pg8::cvt_pk_bf16(v0[0] * sigm(bflo(g.x)), v0[1] * sigm(bfhi(g.x))); w.y = pg8::cvt_pk_bf16(v0[2] * sigm(bflo(g.y)), v0[3] * sigm(bfhi(g.y)));
                    w.z = pg8::cvt_pk_bf16(v1[0] * sigm(bflo(g.z)), v1[1] * sigm(bfhi(g.z))); w.w = pg8::cvt_pk_bf16(v1[2] * sigm(bflo(g.w)), v1[3] * sigm(bfhi(g.w)));
                    *(v4u*)(M + row * DM + col0 + bj * 128) = w; } }
    }
};
struct EpiResid {
    static constexpr bool PERM = false, AFTER_DRAIN = false, HAS_MID = false;
    const float* xa; const float* xb; float* X; const float* gate;
    __device__ __forceinline__ void mid(f32x4 (&)[2][2][4][2], const Unit&, int, int, int, int, int) const {}
    __device__ __forceinline__ void operator()(const f32x4 (&acc)[2][2][4][2], const Unit& u, int wr, int wc, int fr, int fq) const {
        const int row0 = u.pm * 256 + wr * 64 + fr, col0 = u.pn * 256 + wc * 32 + 4 * fq;
        const float* src = u.pm < CB ? xa : xb - (size_t)NCTX * DM;
        const float* gt = gate + (size_t)cond_of(u.pm * 256) * 6 * DM + col0;
        f32x4 gv[2][2];
#pragma unroll
        for (int bj = 0; bj < 2; ++bj)
#pragma unroll
            for (int n = 0; n < 2; ++n) gv[bj][n] = *(const f32x4*)(gt + bj * 128 + n * 16);
#pragma unroll
        for (int ai = 0; ai < 2; ++ai)
#pragma unroll
            for (int m = 0; m < 4; ++m) { const size_t off = (size_t)(row0 + ai * 128 + m * 16) * DM + col0;
#pragma unroll
                for (int bj = 0; bj < 2; ++bj)
#pragma unroll
                    for (int n = 0; n < 2; ++n) { const f32x4 xs = *(const f32x4*)(src + off + bj * 128 + n * 16); *(f32x4*)(X + off + bj * 128 + n * 16) = xs + gv[bj][n] * acc[ai][bj][m][n]; } }
    }
};

__device__ __forceinline__ void p0_transpose_item(const float* W, int K, int N, bf16* WT, LAS float* scr, int item, int lane) {
    const int nblk = N / 32, kb = item / nblk, nb = item % nblk, k0 = 64 * kb, n0 = 32 * nb;
#pragma unroll 8
    for (int i = 0; i < 32; ++i) { const int kk = 2 * i + (lane >> 5); scr[kk * 33 + (lane & 31)] = W[(size_t)(k0 + kk) * N + n0 + (lane & 31)]; }
    LDS_WAIT(); asm volatile("" ::: "memory");
    const int c = lane & 7;
#pragma unroll
    for (int j = 0; j < 4; ++j) { const int n = (lane >> 3) + 8 * j; const LAS float* s = scr + (8 * c) * 33 + n;
        v4u o; o.x = pk2(s[0 * 33], s[1 * 33]); o.y = pk2(s[2 * 33], s[3 * 33]); o.z = pk2(s[4 * 33], s[5 * 33]); o.w = pk2(s[6 * 33], s[7 * 33]);
        *(GAS v4u*)(WT + (size_t)(n0 + n) * K + k0 + 8 * c) = o; }
    LDS_WAIT(); asm volatile("" ::: "memory");
}
__device__ __forceinline__ void sincos_f(float x, float& s, float& c) {
    const float k = rintf(x * 0.63661977236758134f);
    float r = fmaf(k, -1.5707962512969971f, x); r = fmaf(k, -7.5497894158615964e-08f, r); r = fmaf(k, -5.3903025299577648e-15f, r);
    const float r2 = r * r;
    const float sp = r * (1.f + r2 * (-1.6666667163e-01f + r2 * (8.3333337680e-03f + r2 * (-1.9841270114e-04f + r2 * (2.7557314297e-06f + r2 * (-2.5050759689e-08f))))));
    const float cp = 1.f + r2 * (-0.5f + r2 * (4.1666667908e-02f + r2 * (-1.3888889225e-03f + r2 * (2.4801587642e-05f + r2 * (-2.7557314297e-07f + r2 * 2.0876756e-09f)))));
    const int q = ((int)k) & 3;
    s = (q == 0) ? sp : (q == 1) ? cp : (q == 2) ? -sp : -cp;
    c = (q == 0) ? cp : (q == 1) ? -sp : (q == 2) ? -cp : sp;
}

__device__ __forceinline__ void phase_prologue(const Args& A, Frame& F) {
    PHASE_IDS();
    LAS float* scr = (LAS float*)(F.lds + RING_OFF + wave * 16384);
    {
        constexpr int I_IN = (DM / 64) * (NIN / 32), I_GL = (SSMW / 64) * (SSMW / 32), I_BR = (KBR / 64) * (DM / 32), I_OU = (DM / 64) * (DM / 32), I_UP = (DM / 64) * (NUP / 32), I_DN = (DFF / 64) * (DM / 32);
        constexpr int PER_L = I_IN + I_GL + I_BR + I_OU + I_UP + I_DN;
        for (int it = gw; it < DEPTH * PER_L; it += ngw) {
            const int l = it / PER_L; int r = it % PER_L; unsigned char* wl = F.ws + WS_W + (size_t)l * LW_BYTES;
            if (r < I_IN) { p0_transpose_item(IN_(I_WIN) + (size_t)l * DM * NIN, DM, NIN, (bf16*)(wl + LW_IN), scr, r, lane); continue; } r -= I_IN;
            if (r < I_GL) { p0_transpose_item(IN_(I_WGLU) + (size_t)l * SSMW * SSMW, SSMW, SSMW, (bf16*)(wl + LW_GLU), scr, r, lane); continue; } r -= I_GL;
            if (r < I_BR) { p0_transpose_item(IN_(I_WBR) + (size_t)l * KBR * DM, KBR, DM, (bf16*)(wl + LW_BR), scr, r, lane); continue; } r -= I_BR;
            if (r < I_OU) { p0_transpose_item(IN_(I_WOUT) + (size_t)l * DM * DM, DM, DM, (bf16*)(wl + LW_OUT), scr, r, lane); continue; } r -= I_OU;
            if (r < I_UP) { p0_transpose_item(IN_(I_WUP) + (size_t)l * DM * NUP, DM, NUP, (bf16*)(wl + LW_UP), scr, r, lane); continue; } r -= I_UP;
            p0_transpose_item(IN_(I_WDN) + (size_t)l * DFF * DM, DFF, DM, (bf16*)(wl + LW_DN), scr, r, lane);
        }
    }
    __syncthreads();
    {
        LAS float* sc = (LAS float*)(F.lds + RING_OFF);
        float* modp = (float*)(F.ws + WS_MODP);
        for (int task = blockIdx.x; task < DEPTH * 24 * 16; task += F.G) {
            const int ks = task & 15, cg = (task >> 4) % 24, l = task / (16 * 24);
            __syncthreads();
            for (int i = tid; i < 5 * 128; i += NWAVES * 64) { const int j = i >> 7, k = ks * 128 + (i & 127); const float v = j == 0 ? IN_(I_CCTX)[k] : IN_(I_C)[(j - 1) * DM + k]; sc[i] = v * sigm(v); }
            __syncthreads();
            const int n = cg * 512 + tid; const float* W = IN_(I_WMOD) + ((size_t)l * DM + ks * 128) * (6 * DM) + n;
            float a0 = 0.f, a1 = 0.f, a2 = 0.f, a3 = 0.f, a4 = 0.f;
#pragma unroll 8
            for (int k = 0; k < 128; ++k) { const float w = W[(size_t)k * (6 * DM)]; a0 += sc[k] * w; a1 += sc[128 + k] * w; a2 += sc[256 + k] * w; a3 += sc[384 + k] * w; a4 += sc[512 + k] * w; }
            float* o = modp + (((size_t)ks * DEPTH + l) * 5) * (6 * DM) + n;
            o[0] = a0; o[6 * DM] = a1; o[12 * DM] = a2; o[18 * DM] = a3; o[24 * DM] = a4;
        }
    }
    {
        const int gt = blockIdx.x * (NWAVES * 64) + tid, ngt = F.G * NWAVES * 64;
        {
            auto cvt = [&](const float* src, bf16* dst, size_t n) { for (size_t i = (size_t)gt * 8; i < n; i += (size_t)ngt * 8) { const f32x4 a = *(const f32x4*)(src + i), b = *(const f32x4*)(src + i + 4);
                v4u w; w.x = pk2(a.x, a.y); w.y = pk2(a.z, a.w); w.z = pk2(b.x, b.y); w.w = pk2(b.z, b.w); *(v4u*)(dst + i) = w; } };
            cvt(IN_(I_CWK), (bf16*)(F.ws + WS_CWK), SZ_CW); cvt(IN_(I_CWV), (bf16*)(F.ws + WS_CWV), SZ_CW);
            cvt(IN_(I_CNK), (bf16*)(F.ws + WS_CNK), SZ_CN); cvt(IN_(I_CNV), (bf16*)(F.ws + WS_CNV), SZ_CN);
        }
        float* lamt = (float*)(F.ws + WS_SSMT + SSMT_LAM); float* bbt = (float*)(F.ws + WS_SSMT + SSMT_BB);
        for (int i = gt; i < DEPTH * 2 * SG * SP; i += ngt) {
            const float lr = IN_(I_LAMRE)[i], li = IN_(I_LAMIM)[i], dt = expf(IN_(I_LOGDT)[i / SP]);
            float sn, cs; sincos_f(li * dt, sn, cs);
            const float er = expf(lr * dt), lbr = er * cs, lbi = er * sn;
            const float nr = lbr - 1.f, ni = lbi, den = lr * lr + li * li, cr = (nr * lr + ni * li) / den, ci = (ni * lr - nr * li) / den;
            lamt[2 * i] = lbr; lamt[2 * i + 1] = lbi;
            for (int n = 0; n < SN; ++n) { const float br = IN_(I_BRE)[(size_t)i * SN + n], bi = IN_(I_BIM)[(size_t)i * SN + n]; bbt[((size_t)i * SN + n) * 2] = cr * br - ci * bi; bbt[((size_t)i * SN + n) * 2 + 1] = cr * bi + ci * br; }
        }
        float* rope = (float*)(F.ws + WS_ROPE);
        for (int i = gt; i < 64 * 16; i += ngt) { const int comp = i >> 4, f = i & 15; const float inv = exp2f(-(float)f * (13.287712379549449f / 16.f)); float sn, cs; sincos_f((float)comp * inv, sn, cs); rope[comp * 32 + f] = cs; rope[comp * 32 + 16 + f] = sn; }
    }
}
__device__ __forceinline__ void phase_mod_reduce(const Args& A, Frame& F) {
    PHASE_IDS();
    const int gt = blockIdx.x * (NWAVES * 64) + tid, ngt = F.G * NWAVES * 64;
    const float* modp = (const float*)(F.ws + WS_MODP); float* mod = (float*)(F.ws + WS_MOD);
    for (int i = gt; i < DEPTH * 5 * 6 * DM; i += ngt) { const int n = i % (6 * DM), l = i / (5 * 6 * DM); float a = IN_(I_BMOD)[l * 6 * DM + n];
#pragma unroll
        for (int ks = 0; ks < 16; ++ks) a += modp[(size_t)ks * DEPTH * 5 * 6 * DM + i];
        mod[i] = a; }
}
__device__ __forceinline__ void phase_norm(Frame& F, const float* xa, const float* xb, const float* g, const float* mod_l, int s_shift, int s_scale, bf16* H) {
    PHASE_IDS();
    for (int row = gw; row < NTOK; row += ngw) {
        const float* xr = row < NCTX ? xa + (size_t)row * DM : xb + (size_t)(row - NCTX) * DM;
        f32x4 v[8]; float ss = 0.f;
#pragma unroll
        for (int j = 0; j < 8; ++j) { v[j] = *(const f32x4*)(xr + 4 * lane + 256 * j); ss += (v[j].x * v[j].x + v[j].y * v[j].y) + (v[j].z * v[j].z + v[j].w * v[j].w); }
        const float r = 1.0f / sqrtf(wave_sum(ss) * (1.f / DM) + 1e-6f);
        const float* m = mod_l + (size_t)cond_of(row) * 6 * DM;
#pragma unroll
        for (int j = 0; j < 8; ++j) { const int c = 4 * lane + 256 * j; const f32x4 gg = *(const f32x4*)(g + c), sc = *(const f32x4*)(m + s_scale * DM + c), sh = *(const f32x4*)(m + s_shift * DM + c);
            const f32x4 y = v[j] * r * gg * (sc + 1.f) + sh; v2u w; w.x = pk2(y.x, y.y); w.y = pk2(y.z, y.w); *(v2u*)(H + (size_t)row * DM + c) = w; }
    }
}
__device__ __forceinline__ void phase_final_norm(Frame& F, const float* X, const float* g, float* out) {
    PHASE_IDS();
    for (int row = gw; row < NTOK; row += ngw) {
        const float* xr = X + (size_t)row * DM;
        f32x4 v[8]; float ss = 0.f;
#pragma unroll
        for (int j = 0; j < 8; ++j) { v[j] = *(const f32x4*)(xr + 4 * lane + 256 * j); ss += (v[j].x * v[j].x + v[j].y * v[j].y) + (v[j].z * v[j].z + v[j].w * v[j].w); }
        const float r = 1.0f / sqrtf(wave_sum(ss) * (1.f / DM) + 1e-6f);
#pragma unroll
        for (int j = 0; j < 8; ++j) { const int c = 4 * lane + 256 * j; *(f32x4*)(out + (size_t)row * DM + c) = v[j] * r * *(const f32x4*)(g + c); }
    }
}
__device__ __forceinline__ void phase_conv_act(Frame& F, const bf16* U, const float* cw, const float* cb, bf16* act) {
    PHASE_IDS();
    constexpr int NCC = DFF / 256;
    for (int task = gw; task < (NTOK / 16) * NCC; task += ngw) {
        const int rb = task / NCC, cc = task % NCC, t0 = rb * 16, j0 = cc * 256 + 4 * lane;
        const int pos0 = t0 < NCTX ? (t0 & (CL - 1)) : ((t0 - NCTX) & (SL - 1)), L = t0 < NCTX ? CL : SL;
        const f32x4 wa0 = *(const f32x4*)(cw + j0), wa1 = *(const f32x4*)(cw + NUP + j0), wa2 = *(const f32x4*)(cw + 2 * NUP + j0), ba = *(const f32x4*)(cb + j0);
        const f32x4 wb0 = *(const f32x4*)(cw + DFF + j0), wb1 = *(const f32x4*)(cw + NUP + DFF + j0), wb2 = *(const f32x4*)(cw + 2 * NUP + DFF + j0), bb = *(const f32x4*)(cb + DFF + j0);
        const bf16* up = U + (size_t)t0 * NUP + j0;
        auto ld = [&](const bf16* p) { const v2u w = *(const v2u*)p; f32x4 r; r.x = bflo(w.x); r.y = bfhi(w.x); r.z = bflo(w.y); r.w = bfhi(w.y); return r; };
        const f32x4 z = {0.f, 0.f, 0.f, 0.f};
        f32x4 ap = pos0 > 0 ? ld(up - NUP) : z, bp = pos0 > 0 ? ld(up - NUP + DFF) : z, ac = ld(up), bc = ld(up + DFF);
#pragma unroll 4
        for (int r = 0; r < 16; ++r) {
            const bool hn = pos0 + r + 1 < L;
            const f32x4 an = hn ? ld(up + (size_t)(r + 1) * NUP) : z, bn = hn ? ld(up + (size_t)(r + 1) * NUP + DFF) : z;
            const f32x4 a = ba + wa0 * ap + wa1 * ac + wa2 * an, b = bb + wb0 * bp + wb1 * bc + wb2 * bn;
            v2u w; w.x = pk2(a.x * sigm(a.x) * b.x, a.y * sigm(a.y) * b.y); w.y = pk2(a.z * sigm(a.z) * b.z, a.w * sigm(a.w) * b.w);
            *(v2u*)(act + (size_t)(t0 + r) * DFF + j0) = w;
            ap = ac; bp = bc; ac = an; bc = bn;
        }
    }
}
__device__ __forceinline__ void phase_ssm_post(Frame& F, const bf16* P, const float* Ypart, const float* dskip, bf16* Yg) {
    PHASE_IDS();
    for (int row = gw; row < NTOK; row += ngw) {
#pragma unroll
        for (int j = 0; j < 3; ++j) { const int c = 4 * lane + 256 * j;
            const f32x4 yf = *(const f32x4*)(Ypart + (size_t)row * SSMW + c), yb = *(const f32x4*)(Ypart + ((size_t)NTOK + row) * SSMW + c), d = *(const f32x4*)(dskip + c);
            const v2u uw = *(const v2u*)(P + (size_t)row * NIN + C_U + c);
            f32x4 y; y.x = yf.x + yb.x + d.x * bflo(uw.x); y.y = yf.y + yb.y + d.y * bfhi(uw.x); y.z = yf.z + yb.z + d.z * bflo(uw.y); y.w = yf.w + yb.w + d.w * bfhi(uw.y);
            v2u w; w.x = pk2(gelu_tanh(y.x), gelu_tanh(y.y)); w.y = pk2(gelu_tanh(y.z), gelu_tanh(y.w)); *(v2u*)(Yg + (size_t)row * SSMW + c) = w; }
    }
}

__device__ __forceinline__ void phase_ssm(const Args& A, Frame& F, const bf16* P, int l, float* Ypart) {
    PHASE_IDS();
    LAS float* wl = (LAS float*)(F.lds + RING_OFF + wave * 16384);
    LAS float* cre = wl; LAS float* cim = wl + 1024; LAS float* xr = wl + 2048; LAS float* xi = wl + 3072;
    const float* lamt = (const float*)(F.ws + WS_SSMT + SSMT_LAM); const float* bbt = (const float*)(F.ws + WS_SSMT + SSMT_BB);
    const int p = lane;
    for (int unit = gw; unit < (CB + SB) * SG * 2; unit += ngw) {
        const int dir = unit & 1, g = (unit >> 1) % SG; int bb = unit / (2 * SG); bb = bb < SB ? CB + bb : bb - SB;
        const bool ctx = bb < CB; const int base = ctx ? bb * CL : NCTX + (bb - CB) * SL, L = ctx ? CL : SL;
        const size_t pi = (((size_t)l * 2 + dir) * SG + g) * SP + p;
        const float ar = lamt[2 * pi], ai = lamt[2 * pi + 1];
        float bbr[SN], bbi[SN];
#pragma unroll
        for (int n = 0; n < SN; n += 2) { const f32x4 t = *(const f32x4*)(bbt + (pi * SN + n) * 2); bbr[n] = t.x; bbi[n] = t.y; bbr[n + 1] = t.z; bbi[n + 1] = t.w; }
#pragma unroll
        for (int n = 0; n < SN; ++n) { const size_t ci_ = ((((size_t)l * 2 + dir) * SG + g) * SN + n) * SP + p; cre[n * 64 + p] = IN_(I_CRE)[ci_]; cim[n * 64 + p] = IN_(I_CIM)[ci_]; }
        float sr = 0.f, si = 0.f;
        if (!ctx) { const size_t hi = ((((size_t)(bb - CB) * DEPTH + l) * 2 + dir) * SG + g) * SP + p; sr = IN_(I_STRE)[hi]; si = IN_(I_STIM)[hi]; }
        for (int c0 = 0; c0 < L; c0 += 16) {
#pragma unroll 4
            for (int s = 0; s < 16; ++s) {
                const int t = dir == 0 ? c0 + s : L - 1 - (c0 + s);
                const v4u* up = (const v4u*)(P + (size_t)(base + t) * NIN + C_U + g * SN);
                const v4u u0 = up[0], u1 = up[1];
                float uu[16]; uu[0] = bflo(u0.x); uu[1] = bfhi(u0.x); uu[2] = bflo(u0.y); uu[3] = bfhi(u0.y); uu[4] = bflo(u0.z); uu[5] = bfhi(u0.z); uu[6] = bflo(u0.w); uu[7] = bfhi(u0.w);
                uu[8] = bflo(u1.x); uu[9] = bfhi(u1.x); uu[10] = bflo(u1.y); uu[11] = bfhi(u1.y); uu[12] = bflo(u1.z); uu[13] = bfhi(u1.z); uu[14] = bflo(u1.w); uu[15] = bfhi(u1.w);
                float br = 0.f, bi = 0.f;
#pragma unroll
                for (int n = 0; n < SN; ++n) { br += bbr[n] * uu[n]; bi += bbi[n] * uu[n]; }
                const float nr_ = ar * sr - ai * si + br, ni_ = ar * si + ai * sr + bi;
                sr = nr_; si = ni_;
                xr[s * 64 + p] = sr; xi[s * 64 + p] = si;
            }
            LDS_WAIT(); asm volatile("" ::: "memory");
            const int s = p >> 2, nq = p & 3;
            const int t = dir == 0 ? c0 + s : L - 1 - (c0 + s);
            float y[4] = {0.f, 0.f, 0.f, 0.f};
            for (int q = 0; q < SP; ++q) { const float a = xr[s * 64 + q], b = xi[s * 64 + q];
#pragma unroll
                for (int j = 0; j < 4; ++j) y[j] += cre[(nq * 4 + j) * 64 + q] * a - cim[(nq * 4 + j) * 64 + q] * b; }
            *(f32x4*)(Ypart + ((size_t)dir * NTOK + base + t) * SSMW + g * SN + nq * 4) = (f32x4){y[0], y[1], y[2], y[3]};
            LDS_WAIT(); asm volatile("" ::: "memory");
        }
        if (ctx) { const size_t oi = ((((size_t)bb * DEPTH + l) * 2 + dir) * SG + g) * SP + p; F.out[O_SR + oi] = sr; F.out[O_SI + oi] = si; }
    }
}
struct OnlineSm { float m, l; float o[HD]; };
__device__ __forceinline__ void ld8(const bf16* p, float* d) { const v4u w = *(const v4u*)p; d[0] = bflo(w.x); d[1] = bfhi(w.x); d[2] = bflo(w.y); d[3] = bfhi(w.y); d[4] = bflo(w.z); d[5] = bfhi(w.z); d[6] = bflo(w.w); d[7] = bfhi(w.w); }
__device__ __forceinline__ void sm_key_bf(OnlineSm& S, const float (&q)[HD], const bf16* k, const bf16* v, float bias) {
    float s = 0.f;
#pragma unroll
    for (int d = 0; d < HD; d += 8) { float kk[8]; ld8(k + d, kk);
#pragma unroll
        for (int e = 0; e < 8; ++e) s += q[d + e] * kk[e]; }
    s += bias;
    const float mn = fmaxf(S.m, s), corr = __builtin_amdgcn_exp2f(S.m - mn), pp = __builtin_amdgcn_exp2f(s - mn);
    S.l = S.l * corr + pp; S.m = mn;
#pragma unroll
    for (int d = 0; d < HD; d += 8) { float vv[8]; ld8(v + d, vv);
#pragma unroll
        for (int e = 0; e < 8; ++e) S.o[d + e] = S.o[d + e] * corr + pp * vv[e]; }
}
__device__ __forceinline__ void sm_key_f32(OnlineSm& S, const float (&q)[HD], const float* k, const float* v) {
    float s = 0.f;
#pragma unroll
    for (int d = 0; d < HD; d += 4) { const f32x4 a = *(const f32x4*)(k + d); s += q[d] * a.x + q[d + 1] * a.y + q[d + 2] * a.z + q[d + 3] * a.w; }
    const float mn = fmaxf(S.m, s), corr = __builtin_amdgcn_exp2f(S.m - mn), pp = __builtin_amdgcn_exp2f(s - mn);
    S.l = S.l * corr + pp; S.m = mn;
#pragma unroll
    for (int d = 0; d < HD; d += 4) { const f32x4 b = *(const f32x4*)(v + d); S.o[d] = S.o[d] * corr + pp * b.x; S.o[d + 1] = S.o[d + 1] * corr + pp * b.y; S.o[d + 2] = S.o[d + 2] * corr + pp * b.z; S.o[d + 3] = S.o[d + 3] * corr + pp * b.w; }
}
__device__ __forceinline__ void phase_attn_naive(const Args& A, Frame& F, const bf16* P, int l, bf16* Ocat) {
    PHASE_IDS();
    const int gt = blockIdx.x * (NWAVES * 64) + tid, ngt = F.G * NWAVES * 64;
    constexpr float L2E = 1.4426950408889634f;
    for (int task = gt; task < 24 * NTOK; task += ngt) {
        const int h24 = task / NTOK; int tok = task % NTOK; tok = tok < NLAT ? NCTX + tok : tok - NLAT;
        const int mixer = h24 / 12, h = h24 % 12;
        const bool ctx = tok < NCTX;
        const bf16* prow = P + (size_t)tok * NIN;
        float q[HD];
        const int qoff = mixer == 0 ? C_QW + h * HD : C_QN + h * HD;
#pragma unroll
        for (int d = 0; d < HD; d += 8) ld8(prow + qoff + d, q + d);
        OnlineSm S; S.m = -3.0e38f; S.l = 0.f;
#pragma unroll
        for (int d = 0; d < HD; ++d) S.o[d] = 0.f;
        const int koff = mixer == 0 ? C_KW + (h / 3) * HD : C_KN + h * HD, voff = mixer == 0 ? C_VW + (h / 3) * HD : C_VN + h * HD;
        if (ctx) {
            const int b = tok / CL;
            for (int j = 0; j < CL; ++j) { const bf16* kr = P + (size_t)(b * CL + j) * NIN; sm_key_bf(S, q, kr + koff, kr + voff, 0.f); }
        } else {
            const int b = (tok - NCTX) / SL, pos = (tok - NCTX) % SL, base = NCTX + b * SL;
            if (mixer == 0) {
                const int lo = pos - 128 < 0 ? 0 : pos - 128, hi = pos + 128 > SL - 1 ? SL - 1 : pos + 128;
                for (int j = lo; j <= hi; ++j) { const bf16* kr = P + (size_t)(base + j) * NIN; sm_key_bf(S, q, kr + koff, kr + voff, 0.f); }
                const int hk = h / 3;
                for (int c = 0; c < PAST; ++c) { const size_t o = ((((size_t)b * DEPTH + l) * PAST + c) * WINKV + hk) * HD; sm_key_f32(S, q, IN_(I_CWK) + o, IN_(I_CWV) + o); }
            } else {
                const int r = pos / 64, cc = pos % 64;
                int rs = r - 4; rs = rs < 0 ? 0 : (rs > 8 ? 8 : rs);
                int cs = cc - 8; cs = cs < 0 ? 0 : (cs > 48 ? 48 : cs);
                const float* rpb = IN_(I_RPB) + ((size_t)l * NAH + h) * 15 * 31;
                for (int kr_ = rs; kr_ < rs + 8; ++kr_)
                    for (int kc = cs; kc < cs + 16; ++kc) { const bf16* kr = P + (size_t)(base + kr_ * 64 + kc) * NIN; const float bias = rpb[(kr_ - r + 7) * 31 + (kc - cc + 15)] * L2E; sm_key_bf(S, q, kr + koff, kr + voff, bias); }
                for (int c = 0; c < PAST; ++c) { const size_t o = ((((size_t)b * DEPTH + l) * PAST + c) * NAH + h) * HD; sm_key_f32(S, q, IN_(I_CNK) + o, IN_(I_CNV) + o); }
            }
        }
        if (mixer == 0) { const float sk = IN_(I_SINK)[l * WINH + h] * L2E; const float mn = fmaxf(S.m, sk), corr = __builtin_amdgcn_exp2f(S.m - mn); S.l = S.l * corr + __builtin_amdgcn_exp2f(sk - mn);
#pragma unroll
            for (int d = 0; d < HD; ++d) S.o[d] *= corr; }
        const float inv = 1.f / S.l;
        bf16* orow = Ocat + (size_t)tok * KBR + (mixer == 0 ? SSMW : 2 * SSMW) + h * HD;
#pragma unroll
        for (int d = 0; d < HD; d += 8) { v4u w; w.x = pk2(S.o[d] * inv, S.o[d + 1] * inv); w.y = pk2(S.o[d + 2] * inv, S.o[d + 3] * inv); w.z = pk2(S.o[d + 4] * inv, S.o[d + 5] * inv); w.w = pk2(S.o[d + 6] * inv, S.o[d + 7] * inv); *(v4u*)(orow + d) = w; }
    }
}


typedef short bf16x8 __attribute__((ext_vector_type(8)));
typedef short s16x4 __attribute__((ext_vector_type(4)));
typedef float f32x16 __attribute__((ext_vector_type(16)));
typedef float f32x2_t __attribute__((ext_vector_type(2))); typedef __bf16 bf16x2_t __attribute__((ext_vector_type(2)));
__device__ __forceinline__ unsigned cvtpk_s(float lo, float hi) { f32x2_t v = {lo, hi}; bf16x2_t b = __builtin_convertvector(v, bf16x2_t); return __builtin_bit_cast(unsigned, b); }
typedef short v4i16_t __attribute__((ext_vector_type(4)));
__device__ __forceinline__ s16x4 vtr(LAS const unsigned char* p) { return __builtin_bit_cast(s16x4, __builtin_amdgcn_ds_read_tr16_b64_v4i16((LAS v4i16_t*)p)); }
constexpr int AT_KP = 144, AT_KB = 128 * AT_KP, AT_VB = 128 * 128, AT_BUF = AT_KB + AT_VB, AT_BIAS = 2 * AT_BUF;
static_assert(AT_BIAS + 2048 <= RING_BYTES, "attention LDS");
constexpr int N_ATT_UNITS = 768;
__device__ __forceinline__ void phase_attn(const Args& A, Frame& F, const bf16* P, int l, bf16* Ocat) {
    PHASE_IDS();
    LAS unsigned char* lds = F.lds + RING_OFF;
    const int r = lane & 31, h2 = lane >> 5;
    constexpr float L2E = 1.4426950408889634f;
    for (int unit = blockIdx.x; unit < N_ATT_UNITS; unit += F.G) {
        const bool lat = unit < 384; const int uu = lat ? unit : unit - 384;
        int mixer, b, h, qb;
        if (lat) { qb = uu & 3; h = (uu >> 2) % 12; b = (uu / 48) & 3; mixer = uu / 192; } else { qb = 0; h = uu % 12; b = (uu / 12) & 15; mixer = uu / 192; }
        const int tokq0 = lat ? NCTX + b * SL + qb * 256 : b * CL;
        const int hk = mixer == 0 ? h / 3 : h;
        const int qoff = mixer == 0 ? C_QW + h * HD : C_QN + h * HD, koff = mixer == 0 ? C_KW + hk * HD : C_KN + hk * HD, voff = mixer == 0 ? C_VW + hk * HD : C_VN + hk * HD;
        int klo;
        int nloc;
        if (!lat) { klo = 0; nloc = 2; }
        else if (mixer == 0) { klo = qb == 0 ? 0 : qb * 256 - 128; const int khi = qb == 3 ? SL : qb * 256 + 384; nloc = (khi - klo) >> 7; }
        else { klo = qb <= 1 ? 0 : (qb == 2 ? 256 : 512); const int khi = qb == 0 ? 512 : (qb == 1 ? 768 : 1024); nloc = (khi - klo) >> 7; }
        const int nch = nloc + (lat ? 4 : 0);
        const bf16* locK = P + (size_t)((lat ? NCTX + b * SL : b * CL) + klo) * NIN + koff; const bf16* locV = locK + (voff - koff);
        const int cpitch = mixer == 0 ? WINKV * HD : NAH * HD;
        const bf16* cK = (const bf16*)(F.ws + (mixer == 0 ? WS_CWK : WS_CNK)) + (size_t)((b & 3) * DEPTH + l) * PAST * cpitch + hk * HD;
        const bf16* cV = (const bf16*)(F.ws + (mixer == 0 ? WS_CWV : WS_CNV)) + (size_t)((b & 3) * DEPTH + l) * PAST * cpitch + hk * HD;
        LAS float* btab = (LAS float*)(lds + AT_BIAS);
        __syncthreads();
        if (lat && mixer == 1) { if (tid < 465) btab[tid] = IN_(I_RPB)[((size_t)l * NAH + h) * 465 + tid] * L2E; }
        const int qtok = tokq0 + 32 * wave + r;
        bf16x8 qf[4];
#pragma unroll
        for (int s = 0; s < 4; ++s) qf[s] = *(const bf16x8*)(P + (size_t)qtok * NIN + qoff + 16 * s + 8 * h2);
        const int qpos = lat ? qb * 256 + 32 * wave + r : 0;
        const int qr = qpos >> 6, qc = qpos & 63;
        const int rs = qr < 4 ? 0 : (qr > 12 ? 8 : qr - 4), cs = qc < 8 ? 0 : (qc > 56 ? 48 : qc - 8);
        const int wq0 = lat ? qb * 256 + 32 * wave : 0;
        const int wqr = wq0 >> 6, wrs = wqr < 4 ? 0 : (wqr > 12 ? 8 : wqr - 4);
        v4u kreg[2], vreg[2];
        auto gload = [&](int c) {
            const bf16* kb; const bf16* vb; size_t pitch;
            if (c < nloc) { kb = locK + (size_t)c * 128 * NIN; vb = locV + (size_t)c * 128 * NIN; pitch = NIN; } else { kb = cK + (size_t)(c - nloc) * 128 * cpitch; vb = cV + (size_t)(c - nloc) * 128 * cpitch; pitch = cpitch; }
#pragma unroll
            for (int i = 0; i < 2; ++i) { const int pid = tid + 512 * i, key = pid >> 3, part = pid & 7; kreg[i] = *(const v4u*)(kb + (size_t)key * pitch + part * 8); vreg[i] = *(const v4u*)(vb + (size_t)key * pitch + part * 8); }
        };
        auto lstore = [&](int buf) {
            LAS unsigned char* kb = lds + buf * AT_BUF; LAS unsigned char* vb = kb + AT_KB;
#pragma unroll
            for (int i = 0; i < 2; ++i) { const int pid = tid + 512 * i, key = pid >> 3, part = pid & 7; *(LAS v4u*)(kb + key * AT_KP + part * 16) = kreg[i]; *(LAS v4u*)(vb + (part >> 2) * 8192 + key * 64 + (part & 3) * 16) = vreg[i]; }
        };
        f32x16 oT[2]; float m_run = -1.0e30f, l_run = 0.f;
#pragma unroll
        for (int i = 0; i < 16; ++i) { oT[0][i] = 0.f; oT[1][i] = 0.f; }
        gload(0); lstore(0);
        __syncthreads();
        for (int c = 0; c < nch; ++c) {
            if (c + 1 < nch) gload(c + 1);
            LAS const unsigned char* kb = lds + (c & 1) * AT_BUF; LAS const unsigned char* vb = kb + AT_KB;
            const bool local = c < nloc;
#pragma unroll 1
            for (int t = 0; t < 4; ++t) {
                const int kp0 = klo + c * 128 + t * 32;
                if (lat && local) {
                    if (mixer == 0) { if (kp0 + 31 < wq0 - 128 || kp0 > wq0 + 31 + 128) continue; }
                    else { const int kr = kp0 >> 6; if (kr < wrs || kr >= wrs + 8) continue; }
                }
                f32x16 S;
#pragma unroll
                for (int i = 0; i < 16; ++i) S[i] = 0.f;
#pragma unroll
                for (int s = 0; s < 4; ++s) { const bf16x8 kf = *(LAS const bf16x8*)(kb + (t * 32 + r) * AT_KP + 32 * s + 16 * h2); S = __builtin_amdgcn_mfma_f32_32x32x16_bf16(kf, qf[s], S, 0, 0, 0); }
                if (lat && local) {
                    if (mixer == 0) {
#pragma unroll
                        for (int i = 0; i < 16; ++i) { const int kp = kp0 + (i & 3) + 8 * (i >> 2) + 4 * h2; const int d = kp - qpos; if (d > 128 || d < -128) S[i] = -INFINITY; }
                    } else {
                        const int kr = kp0 >> 6; const bool rok = kr >= rs && kr < rs + 8; const int brow = (kr - qr + 7) * 31 - qc + 15;
#pragma unroll
                        for (int i = 0; i < 16; ++i) { const int kc = (kp0 & 63) + (i & 3) + 8 * (i >> 2) + 4 * h2; const bool ok = rok && kc >= cs && kc < cs + 16;
                            const float bv = btab[ok ? brow + kc : 0]; S[i] = ok ? S[i] + bv : -INFINITY; }
                    }
                }
                float mx = S[0];
#pragma unroll
                for (int i = 1; i < 16; ++i) mx = fmaxf(mx, S[i]);
                mx = fmaxf(mx, __shfl_xor(mx, 32));
                const float mn = fmaxf(m_run, mx), alpha = __builtin_amdgcn_exp2f(m_run - mn);
                m_run = mn;
                float ps = 0.f;
#pragma unroll
                for (int i = 0; i < 16; ++i) { S[i] = __builtin_amdgcn_exp2f(S[i] - mn); ps += S[i]; }
                l_run = l_run * alpha + ps;
#pragma unroll
                for (int i = 0; i < 16; ++i) { oT[0][i] *= alpha; oT[1][i] *= alpha; }
#pragma unroll
                for (int s2 = 0; s2 < 2; ++s2) {
                    v4u pw; pw.x = cvtpk_s(S[8 * s2], S[8 * s2 + 1]); pw.y = cvtpk_s(S[8 * s2 + 2], S[8 * s2 + 3]); pw.z = cvtpk_s(S[8 * s2 + 4], S[8 * s2 + 5]); pw.w = cvtpk_s(S[8 * s2 + 6], S[8 * s2 + 7]);
                    const bf16x8 pf = __builtin_bit_cast(bf16x8, pw);
                    const int i16 = lane & 15, q4 = i16 >> 2, p4 = i16 & 3, blk = (lane >> 4) & 1;
#pragma unroll
                    for (int dh = 0; dh < 2; ++dh) {
                        LAS const unsigned char* vp = vb + dh * 8192 + (t * 32 + 16 * s2 + 4 * h2 + q4) * 64 + 32 * blk + 8 * p4;
                        const s16x4 lo = vtr(vp), hi = vtr(vp + 8 * 64);
                        const bf16x8 vf = (bf16x8){lo[0], lo[1], lo[2], lo[3], hi[0], hi[1], hi[2], hi[3]};
                        oT[dh] = __builtin_amdgcn_mfma_f32_32x32x16_bf16(vf, pf, oT[dh], 0, 0, 0);
                    }
                }
            }
            if (c + 1 < nch) lstore((c + 1) & 1);
            __syncthreads();
        }
        float lt = l_run + __shfl_xor(l_run, 32);
        if (mixer == 0) lt += __builtin_amdgcn_exp2f(IN_(I_SINK)[l * WINH + h] * L2E - m_run);
        const float inv = 1.f / lt;
        bf16* orow = Ocat + (size_t)qtok * KBR + (mixer == 0 ? SSMW : 2 * SSMW) + h * HD;
#pragma unroll
        for (int dh = 0; dh < 2; ++dh)
#pragma unroll
            for (int g4 = 0; g4 < 4; ++g4) { v2u w; w.x = cvtpk_s(oT[dh][4 * g4] * inv, oT[dh][4 * g4 + 1] * inv); w.y = cvtpk_s(oT[dh][4 * g4 + 2] * inv, oT[dh][4 * g4 + 3] * inv);
                *(v2u*)(orow + 32 * dh + 8 * g4 + 4 * h2) = w; }
    }
}

constexpr int PH_PRO = 0, PH_MODR = 1, PH_L0 = 2, PPL = 11, PH_FINAL = PH_L0 + PPL * DEPTH, N_PHASES = PH_FINAL + 1;
__global__ void __launch_bounds__(NWAVES * 64, 2) fwd(Args args) {
    extern __shared__ __attribute__((aligned(16))) unsigned char lds[];
    const Args& A = args;
    Frame F;
    F.lds = (LAS unsigned char*)lds; F.MISC = (volatile LAS unsigned*)(F.lds + MISC_OFF);
    F.G = gridDim.x;
    F.out = args.out; F.ws = args.ws; F.ctl = (gu32*)(args.ws + WS_CTL);
    for (int u = threadIdx.x; u < (LDS_BYTES - LDSCTL_OFF) / 4; u += NWAVES * 64) ((LAS unsigned*)(F.lds + LDSCTL_OFF))[u] = 0u;
    __syncthreads();
    XcdBarrier bar; bar.bar = (unsigned*)(F.ctl + CW_BAR); bar.x = 0; bar.st = nullptr;
    if (!MK_PER_PHASE) bar = xcd_barrier_post((unsigned*)(F.ctl + CW_BAR), F.MISC + 8);
    const int lo = args.ph_lo, hi = args.ph_hi;
#define IN(k) (lo <= (k) && (k) < hi)
#define SEAM(k) do { if (IN(k) && IN((k) + 1)) xcd_barrier(bar); } while (0)
    unsigned char* ws = args.ws;
    float* X = (float*)(ws + WS_X); bf16* H = (bf16*)(ws + WS_H); bf16* PU = (bf16*)(ws + WS_PU); float* Yp = (float*)(ws + WS_YF); bf16* Yg = (bf16*)(ws + WS_YG);
    bf16* Oc = (bf16*)(ws + WS_OC); bf16* Mb = (bf16*)(ws + WS_MB); bf16* act = (bf16*)(ws + WS_ACT);
    const float* mod = (const float*)(ws + WS_MOD);

    if (IN(PH_PRO)) { phase_prologue(args, F); } SEAM(PH_PRO);
    if (IN(PH_MODR)) { phase_mod_reduce(args, F); } SEAM(PH_MODR);
    for (int l = 0; l < DEPTH; ++l) {
        const int pb = PH_L0 + PPL * l;
        const float* mod_l = mod + (size_t)l * 5 * 6 * DM;
        unsigned char* wl = ws + WS_W + (size_t)l * LW_BYTES;
        const float* xa = l == 0 ? IN_(I_XP) : X; const float* xb = l == 0 ? IN_(I_XS) : X + (size_t)NCTX * DM;
        if (IN(pb + 0)) { phase_norm(F, xa, xb, IN_(I_N1G) + (size_t)l * DM, mod_l, 0, 1, H); } SEAM(pb + 0);
        if (IN(pb + 1)) { pg8::Gemm g{H, (const bf16*)(wl + LW_IN), NTOK, NIN, DM}; pg8::StaticOrder S; S.init(NTOK, NIN, F.G, (int)blockIdx.x);
            EpiInProj E{PU, F.out, (const float*)(ws + WS_ROPE), l};
            pg8::gemm_phase<EpiInProj, pg8::StaticOrder, true, true>(F.lds + RING_OFF, g, S, E); } SEAM(pb + 1);
        if (IN(pb + 2)) { phase_ssm(args, F, PU, l, Yp); __syncthreads(); phase_attn(args, F, PU, l, Oc); } SEAM(pb + 2);
        if (IN(pb + 3)) { phase_ssm_post(F, PU, Yp, IN_(I_SSMD) + (size_t)l * SSMW, Yg); } SEAM(pb + 3);
        if (IN(pb + 4)) { pg8::Gemm g{Yg, (const bf16*)(wl + LW_GLU), NTOK, SSMW, SSMW}; pg8::StaticOrder S; S.init(NTOK, SSMW, F.G, (int)blockIdx.x);
            EpiGlu E{Yg, Oc, IN_(I_BGLU) + (size_t)l * SSMW};
            pg8::gemm_phase<EpiGlu, pg8::StaticOrder, true, true>(F.lds + RING_OFF, g, S, E); } SEAM(pb + 4);
        if (IN(pb + 5)) { pg8::Gemm g{Oc, (const bf16*)(wl + LW_BR), NTOK, DM, KBR}; pg8::StaticOrder S; S.init(NTOK, DM, F.G, (int)blockIdx.x);
            EpiBranch E{PU, Mb};
            pg8::gemm_phase<EpiBranch, pg8::StaticOrder, true, true>(F.lds + RING_OFF, g, S, E); } SEAM(pb + 5);
        if (IN(pb + 6)) { pg8::Gemm g{Mb, (const bf16*)(wl + LW_OUT), NTOK, DM, DM}; pg8::StaticOrder S; S.init(NTOK, DM, F.G, (int)blockIdx.x);
            EpiResid E{xa, xb, X, mod_l + 2 * DM};
            pg8::gemm_phase<EpiResid, pg8::StaticOrder, true, true>(F.lds + RING_OFF, g, S, E); } SEAM(pb + 6);
        if (IN(pb + 7)) { phase_norm(F, X, X + (size_t)NCTX * DM, IN_(I_N2G) + (size_t)l * DM, mod_l, 3, 4, H); } SEAM(pb + 7);
        if (IN(pb + 8)) { pg8::Gemm g{H, (const bf16*)(wl + LW_UP), NTOK, NUP, DM}; pg8::StaticOrder S; S.init(NTOK, NUP, F.G, (int)blockIdx.x);
            EpiBf16Plain E{PU, NUP};
            pg8::gemm_phase<EpiBf16Plain, pg8::StaticOrder, true, true>(F.lds + RING_OFF, g, S, E); } SEAM(pb + 8);
        if (IN(pb + 9)) { phase_conv_act(F, PU, IN_(I_CONVW) + (size_t)l * 3 * NUP, IN_(I_CONVB) + (size_t)l * NUP, act); } SEAM(pb + 9);
        if (IN(pb + 10)) { pg8::Gemm g{act, (const bf16*)(wl + LW_DN), NTOK, DM, DFF}; pg8::StaticOrder S; S.init(NTOK, DM, F.G, (int)blockIdx.x);
            EpiResid E{X, X + (size_t)NCTX * DM, X, mod_l + 5 * DM};
            pg8::gemm_phase<EpiResid, pg8::StaticOrder, true, true>(F.lds + RING_OFF, g, S, E); } SEAM(pb + 10);
    }
    if (IN(PH_FINAL)) { phase_final_norm(F, X, IN_(I_FING), F.out); }
#undef IN
#undef SEAM
}

extern "C" void kernel_launch(void* const* d_in, const int* in_sizes, int n_in, void* d_out, int out_size, void* d_ws, size_t ws_size, hipStream_t stream) {
    static int grid = 0;
    if (grid == 0) {
        if (n_in != 34 || (size_t)out_size != O_END || ws_size < WS_END) { fprintf(stderr, "kernel_launch: unexpected problem shape (n_in %d, out %d, ws %zu, need %zu)\n", n_in, out_size, ws_size, (size_t)WS_END); grid = -1; return; }
        int dev = 0, cus = 0, per_cu = 0;
        if (hipGetDevice(&dev) != hipSuccess || hipDeviceGetAttribute(&cus, hipDeviceAttributeMultiprocessorCount, dev) != hipSuccess) { grid = -1; return; }
        if (hipFuncSetAttribute((const void*)fwd, hipFuncAttributeMaxDynamicSharedMemorySize, LDS_BYTES) != hipSuccess) { fprintf(stderr, "kernel_launch: hipFuncSetAttribute failed\n"); grid = -1; return; }
        if (hipOccupancyMaxActiveBlocksPerMultiprocessor(&per_cu, (const void*)fwd, NWAVES * 64, LDS_BYTES) != hipSuccess || per_cu < 1) { fprintf(stderr, "kernel_launch: occupancy query says %d\n", per_cu); }
        (void)hipGetLastError();
        grid = cus;
    }
    if (grid < 0) return;
    if (hipMemsetAsync((char*)d_ws + WS_CTL, 0, CTL_ZERO_BYTES, stream) != hipSuccess) return;
    Args a{};
    for (int i = 0; i < 34; ++i) a.in[i] = (const float*)d_in[i];
    a.out = (float*)d_out; a.ws = (unsigned char*)d_ws;
#if MK_PER_PHASE
    for (int p = 0; p < N_PHASES; ++p) { a.ph_lo = p; a.ph_hi = p + 1; hipLaunchKernelGGL(fwd, dim3(grid), dim3(NWAVES * 64), LDS_BYTES, stream, a); }
#else
    a.ph_lo = 0; a.ph_hi = N_PHASES; hipLaunchKernelGGL(fwd, dim3(grid), dim3(NWAVES * 64), LDS_BYTES, stream, a);
#endif
}
```
